# Optimizing an MI355X kernel written in HIP

```python
import math
import jax
import jax.numpy as jnp
from jax import lax
import numpy as np

D_MODEL = 1024
BATCH = 2
SEQ = 8192
DEPTH = 1

D_MIX = D_MODEL
GDN_HEADS = 4
GDN_HEAD_DIM = 128
GDN_WIDTH = GDN_HEADS * GDN_HEAD_DIM
CONV_WIDTH = 5
CHUNK = 64
SWA_HEADS = 8
SWA_HEAD_DIM = 64
SWA_WIDTH = SWA_HEADS * SWA_HEAD_DIM
DILATION_PATTERNS = ((128, 1), (512, 4), (2048, 16))
BAND_BLOCK = 64
REL_BUCKETS = 32
REL_MAX_DISTANCE = 1024
D_FF = 2816
EPS = 1e-6
NEG_BIG = -1e30
SPLITS = (3 * GDN_WIDTH, GDN_WIDTH, 2 * GDN_HEADS, 2 * GDN_HEADS, 3 * SWA_WIDTH)
N_IN = sum(SPLITS)

kernel_name = "hybrid_gdn_dilated_swa_macaron"


def rms_norm(x, w):
    xf = x.astype(jnp.float32)
    y = xf * lax.rsqrt(jnp.mean(xf * xf, axis=-1, keepdims=True) + EPS)
    return (y * w.astype(jnp.float32)).astype(x.dtype)


def l2_normalize(x):
    return x * lax.rsqrt(jnp.sum(x * x, axis=-1, keepdims=True) + EPS)


def swiglu(x, w_gate, w_up, w_down):
    return (jax.nn.silu(x @ w_gate) * (x @ w_up)) @ w_down


def t5_bucket(rel):
    nb = REL_BUCKETS // 2
    bucket = (rel > 0).astype(np.int32) * nb
    n = np.abs(rel)
    max_exact = nb // 2
    large = max_exact + (np.log(np.maximum(n, 1) / max_exact)
                         / math.log(REL_MAX_DISTANCE / max_exact) * (nb - max_exact)).astype(np.int32)
    large = np.minimum(large, nb - 1)
    return (bucket + np.where(n < max_exact, n, large)).astype(np.int32)


def short_conv(x, w):
    c, kw = w.shape
    rhs = jnp.transpose(w).astype(x.dtype)[:, None, :]
    return lax.conv_general_dilated(x, rhs, window_strides=(1,),
                                    padding=((kw // 2, kw // 2),),
                                    dimension_numbers=('NWC', 'WIO', 'NWC'),
                                    feature_group_count=c)


def gated_delta_chunked(q, k, v, g, beta):
    b, h, t, dk = q.shape
    dv = v.shape[-1]
    nc = t // CHUNK
    q = q * (dk ** -0.5)

    def chunks(a):
        return a.reshape(b, h, nc, CHUNK, *a.shape[3:])

    q, k, v, g, beta = chunks(q), chunks(k), chunks(v), chunks(g), chunks(beta)
    g = jnp.cumsum(g, axis=-1)
    incl = jnp.tril(jnp.ones((CHUNK, CHUNK), dtype=bool))
    strict = jnp.tril(jnp.ones((CHUNK, CHUNK), dtype=bool), -1)
    diff = g[..., :, None] - g[..., None, :]
    decay = jnp.where(incl, jnp.exp(jnp.where(incl, diff, 0.0)), 0.0)
    kb = k * beta[..., None]
    lmat = jnp.where(strict, jnp.einsum('bhncd,bhnjd->bhncj', kb, k) * decay, 0.0)
    eye = jnp.eye(CHUNK, dtype=jnp.float32)
    tmat = lax.linalg.triangular_solve(eye + lmat, jnp.broadcast_to(eye, lmat.shape),
                                       left_side=True, lower=True, unit_diagonal=True)
    u = tmat @ (v * beta[..., None])
    w = tmat @ (kb * jnp.exp(g)[..., None])
    intra = jnp.einsum('bhncd,bhnjd->bhncj', q, k) * decay
    qg = q * jnp.exp(g)[..., None]
    g_last = g[..., -1]
    kdec = k * jnp.exp(g_last[..., None] - g)[..., None]

    def step(state, inp):
        u_c, w_c, qg_c, intra_c, kdec_c, gl_c = inp
        v_new = u_c - w_c @ state
        o_c = qg_c @ state + intra_c @ v_new
        state = state * jnp.exp(gl_c)[..., None, None] + jnp.swapaxes(kdec_c, -1, -2) @ v_new
        return state, o_c

    xs = tuple(jnp.moveaxis(a, 2, 0) for a in (u, w, qg, intra, kdec, g_last))
    state0 = jnp.zeros((b, h, dk, dv), jnp.float32)
    _, o = lax.scan(step, state0, xs)
    return jnp.moveaxis(o, 0, 2).reshape(b, h, t, dv)


def _reverse(a):
    return jnp.flip(a, axis=2)


def gdn_mixer(qkv, z, a, beta_logit, conv_w, a_log, dt_bias, norm_w):
    b, s, _ = qkv.shape
    f32 = jnp.float32
    qkv = jax.nn.silu(short_conv(qkv, conv_w)).astype(f32)
    qkv = qkv.reshape(b, s, 3, GDN_HEADS, GDN_HEAD_DIM).transpose(2, 0, 3, 1, 4)
    q, k, v = l2_normalize(qkv[0]), l2_normalize(qkv[1]), qkv[2]
    a = a.astype(f32).reshape(b, s, 2, GDN_HEADS)
    g = -jnp.exp(a_log.astype(f32)) * jax.nn.softplus(a + dt_bias.astype(f32))
    beta = jax.nn.sigmoid(beta_logit.astype(f32).reshape(b, s, 2, GDN_HEADS))
    g = g.transpose(2, 0, 3, 1)
    beta = beta.transpose(2, 0, 3, 1)
    o_fwd = gated_delta_chunked(q, k, v, g[0], beta[0])
    o_bwd = _reverse(gated_delta_chunked(_reverse(q), _reverse(k), _reverse(v),
                                         _reverse(g[1]), _reverse(beta[1])))
    o = (o_fwd + o_bwd).transpose(0, 2, 1, 3)
    zg = jax.nn.silu(z.astype(f32).reshape(b, s, GDN_HEADS, GDN_HEAD_DIM))
    o = rms_norm(o, norm_w) * zg
    return o.reshape(b, s, GDN_WIDTH).astype(z.dtype)


def dilated_band_attention(q, k, v, rel_bias, window, dilation):
    b, s, h, dh = q.shape
    radius = window // (2 * dilation)
    blk = BAND_BLOCK
    length = s // dilation
    nb = -(-length // blk)
    lp = nb * blk

    def to_blocks(a):
        a = a.reshape(b, length, dilation, h, dh).transpose(0, 2, 3, 1, 4)
        a = jnp.pad(a, ((0, 0), (0, 0), (0, 0), (0, lp - length), (0, 0)))
        return a.reshape(b, dilation, h, nb, blk, dh)

    def band(a):
        ap = jnp.pad(a, ((0, 0), (0, 0), (0, 0), (1, 1), (0, 0), (0, 0)))
        return jnp.concatenate([ap[:, :, :, :-2], ap[:, :, :, 1:-1], ap[:, :, :, 2:]], axis=-2)

    qb = to_blocks(q)
    kw = band(to_blocks(k))
    vw = band(to_blocks(v))
    qi = np.arange(blk)[:, None]
    ki = np.arange(3 * blk)[None, :]
    rel = ki - blk - qi
    key_t = (np.arange(nb)[:, None, None] - 1) * blk + ki[None]
    valid = (np.abs(rel)[None] <= radius) & (key_t >= 0) & (key_t < length)
    bias = jnp.transpose(rel_bias[t5_bucket(rel * dilation)], (2, 0, 1))[:, None]
    logits = jnp.einsum('bdhnqe,bdhnke->bdhnqk', qb, kw, preferred_element_type=jnp.float32)
    logits = jnp.where(valid, logits + bias.astype(jnp.float32), NEG_BIG)
    m = jnp.max(logits, axis=-1, keepdims=True)
    p = jnp.exp(logits - m)
    den = jnp.sum(p, axis=-1, keepdims=True)
    o = jnp.einsum('bdhnqk,bdhnke->bdhnqe', p, vw.astype(jnp.float32)) / den
    lse = (m + jnp.log(den))[..., 0]
    o = o.reshape(b, dilation, h, lp, dh)[:, :, :, :length].transpose(0, 3, 1, 2, 4).reshape(b, s, h, dh)
    lse = lse.reshape(b, dilation, h, lp)[..., :length].transpose(0, 3, 1, 2).reshape(b, s, h)
    return o, lse


def dilated_mixer(qkv, q_norm_w, k_norm_w, rel_bias):
    b, s, _ = qkv.shape
    qkv = qkv.reshape(b, s, 3, SWA_HEADS, SWA_HEAD_DIM)
    q = rms_norm(qkv[:, :, 0], q_norm_w) * (SWA_HEAD_DIM ** -0.5)
    k = rms_norm(qkv[:, :, 1], k_norm_w)
    v = qkv[:, :, 2]
    outs, lses = [], []
    for window, dilation in DILATION_PATTERNS:
        o_p, lse_p = dilated_band_attention(q, k, v, rel_bias, window, dilation)
        outs.append(o_p)
        lses.append(lse_p)
    wts = jax.nn.softmax(jnp.stack(lses, axis=0), axis=0)
    o = jnp.sum(wts[..., None] * jnp.stack(outs, axis=0), axis=0)
    return o.reshape(b, s, SWA_WIDTH).astype(qkv.dtype)


def setup_inputs(seed: int = 0) -> dict:
    key = jax.random.key(seed)
    ks = jax.random.split(key, 24)
    f32 = jnp.float32

    def dense(k, shape, fan_in):
        return jax.random.normal(k, shape, f32) * (fan_in ** -0.5)

    def gain(k, shape):
        return 1.0 + 0.02 * jax.random.normal(k, shape, f32)

    x = jax.random.normal(ks[0], (BATCH, SEQ, D_MODEL), f32)
    ffn1_norm = gain(ks[1], (DEPTH, D_MODEL))
    ffn1_w_gate = dense(ks[2], (DEPTH, D_MODEL, D_FF), D_MODEL)
    ffn1_w_up = dense(ks[3], (DEPTH, D_MODEL, D_FF), D_MODEL)
    ffn1_w_down = dense(ks[4], (DEPTH, D_FF, D_MODEL), D_FF)
    mix_norm = gain(ks[5], (DEPTH, D_MODEL))
    w_in = dense(ks[6], (DEPTH, D_MODEL, N_IN), D_MODEL)
    conv_w = dense(ks[7], (DEPTH, 3 * GDN_WIDTH, CONV_WIDTH), CONV_WIDTH)
    a_log = jnp.log(jax.random.uniform(ks[8], (DEPTH, 2, GDN_HEADS), f32, 1.0, 16.0))
    dt = jnp.exp(jax.random.uniform(ks[9], (DEPTH, 2, GDN_HEADS), f32, math.log(1e-3), math.log(1e-1)))
    dt_bias = dt + jnp.log(-jnp.expm1(-dt))
    gdn_norm_w = gain(ks[10], (DEPTH, GDN_HEAD_DIM))
    q_norm_w = gain(ks[11], (DEPTH, SWA_HEAD_DIM))
    k_norm_w = gain(ks[12], (DEPTH, SWA_HEAD_DIM))
    rel_bias = 0.2 * jax.random.normal(ks[13], (REL_BUCKETS, SWA_HEADS), f32)
    w_out = dense(ks[14], (DEPTH, D_MIX, D_MODEL), D_MIX)
    ffn2_norm = gain(ks[15], (DEPTH, D_MODEL))
    ffn2_w_gate = dense(ks[16], (DEPTH, D_MODEL, D_FF), D_MODEL)
    ffn2_w_up = dense(ks[17], (DEPTH, D_MODEL, D_FF), D_MODEL)
    ffn2_w_down = dense(ks[18], (DEPTH, D_FF, D_MODEL), D_FF)
    final_norm = gain(ks[19], (DEPTH, D_MODEL))
    return {"x": x, "ffn1_norm": ffn1_norm, "ffn1_w_gate": ffn1_w_gate, "ffn1_w_up": ffn1_w_up,
            "ffn1_w_down": ffn1_w_down, "mix_norm": mix_norm, "w_in": w_in, "conv_w": conv_w,
            "a_log": a_log, "dt_bias": dt_bias, "gdn_norm_w": gdn_norm_w, "q_norm_w": q_norm_w,
            "k_norm_w": k_norm_w, "rel_bias": rel_bias, "w_out": w_out, "ffn2_norm": ffn2_norm,
            "ffn2_w_gate": ffn2_w_gate, "ffn2_w_up": ffn2_w_up, "ffn2_w_down": ffn2_w_down,
            "final_norm": final_norm}


def reference(x, ffn1_norm, ffn1_w_gate, ffn1_w_up, ffn1_w_down, mix_norm, w_in, conv_w,
              a_log, dt_bias, gdn_norm_w, q_norm_w, k_norm_w, rel_bias, w_out, ffn2_norm,
              ffn2_w_gate, ffn2_w_up, ffn2_w_down, final_norm):
    split_at = np.cumsum(SPLITS)[:-1].tolist()
    for l in range(DEPTH):
        x = x + 0.5 * swiglu(rms_norm(x, ffn1_norm[l]), ffn1_w_gate[l], ffn1_w_up[l], ffn1_w_down[l])
        h = rms_norm(x, mix_norm[l])
        proj = h @ w_in[l]
        qkv_a, z_a, a_a, b_a, qkv_b = jnp.split(proj, split_at, axis=-1)
        o_a = gdn_mixer(qkv_a, z_a, a_a, b_a, conv_w[l], a_log[l], dt_bias[l], gdn_norm_w[l])
        o_b = dilated_mixer(qkv_b, q_norm_w[l], k_norm_w[l], rel_bias)
        x = x + jnp.concatenate([o_a, o_b], axis=-1) @ w_out[l]
        x = x + 0.5 * swiglu(rms_norm(x, ffn2_norm[l]), ffn2_w_gate[l], ffn2_w_up[l], ffn2_w_down[l])
        x = rms_norm(x, final_norm[l])
    return x
```

```cpp
#include <hip/hip_runtime.h>
#include <cstdio>
#include <cstdint>

namespace ref {
constexpr int D_MODEL = 1024, BATCH = 2, SEQ = 8192, M = BATCH * SEQ;
constexpr int GH = 4, GD = 128, GW = 512, CONVW = 5;
constexpr int AH = 8, AD = 64, AW = 512;
constexpr int D_FF = 2816, N_IN = 3600;
constexpr float EPS = 1e-6f;
constexpr int C_QKVA = 0, C_Z = 1536, C_A = 2048, C_B = 2056, C_QKVB = 2064;

__device__ const unsigned char BUCKET[3][129] = {
 {11,11,11,11,11,11,11,11,11,11,11,11,11,11,11,10,10,10,10,10,10,10,10,10,10,10,10,10,10,10,10,10,10,10,10,10,10,10,9,9,9,9,9,9,9,9,9,9,9,9,8,8,8,8,8,8,8,7,6,5,4,3,2,1,0,17,18,19,20,21,22,23,24,24,24,24,24,24,24,25,25,25,25,25,25,25,25,25,25,25,25,26,26,26,26,26,26,26,26,26,26,26,26,26,26,26,26,26,26,26,26,26,26,26,27,27,27,27,27,27,27,27,27,27,27,27,27,27,27},
 {13,13,13,13,13,13,13,13,13,13,13,13,13,13,13,13,13,13,13,13,13,13,13,12,12,12,12,12,12,12,12,12,12,12,12,12,12,12,12,12,12,12,11,11,11,11,11,11,11,11,11,11,10,10,10,10,10,10,9,9,9,8,8,4,0,20,24,24,25,25,25,26,26,26,26,26,26,27,27,27,27,27,27,27,27,27,27,28,28,28,28,28,28,28,28,28,28,28,28,28,28,28,28,28,28,28,29,29,29,29,29,29,29,29,29,29,29,29,29,29,29,29,29,29,29,29,29,29,29},
 {15,15,15,15,15,15,15,15,15,15,15,15,15,15,15,15,15,15,15,15,15,15,15,15,15,15,15,15,15,15,14,14,14,14,14,14,14,14,14,14,14,14,14,14,14,13,13,13,13,13,13,13,13,13,12,12,12,12,12,11,11,10,10,9,0,25,26,26,27,27,28,28,28,28,28,29,29,29,29,29,29,29,29,29,30,30,30,30,30,30,30,30,30,30,30,30,30,30,30,31,31,31,31,31,31,31,31,31,31,31,31,31,31,31,31,31,31,31,31,31,31,31,31,31,31,31,31,31,31}};

__device__ __forceinline__ float wave_sum(float v) {
#pragma unroll
    for (int o = 1; o < 64; o <<= 1) v += __shfl_xor(v, o);
    return v;
}
__device__ __forceinline__ float wave_max(float v) {
#pragma unroll
    for (int o = 1; o < 64; o <<= 1) v = fmaxf(v, __shfl_xor(v, o));
    return v;
}
__device__ __forceinline__ float silu(float x) { return x / (1.f + __expf(-x)); }

__global__ void __launch_bounds__(256) rmsnorm_k(const float* in, const float* __restrict__ w, float* out, int rows) {
    const int row = blockIdx.x * 4 + (threadIdx.x >> 6), lane = threadIdx.x & 63;
    if (row >= rows) return;
    const float4* p = (const float4*)(in + (size_t)row * D_MODEL);
    float4 v[4]; float s = 0.f;
#pragma unroll
    for (int j = 0; j < 4; ++j) { v[j] = p[lane + 64 * j]; s += v[j].x * v[j].x + v[j].y * v[j].y + v[j].z * v[j].z + v[j].w * v[j].w; }
    s = wave_sum(s);
    const float r = rsqrtf(s * (1.f / D_MODEL) + EPS);
    float4* o = (float4*)(out + (size_t)row * D_MODEL);
    const float4* wp = (const float4*)w;
#pragma unroll
    for (int j = 0; j < 4; ++j) { float4 ww = wp[lane + 64 * j]; float4 t; t.x = v[j].x * r * ww.x; t.y = v[j].y * r * ww.y; t.z = v[j].z * r * ww.z; t.w = v[j].w * r * ww.w; o[lane + 64 * j] = t; }
}

template <int MODE>
__global__ void __launch_bounds__(256) sgemm_k(const float* __restrict__ A, int lda, const float* __restrict__ B, const float* __restrict__ B2, int ldb,
                                               float* C, int ldc, const float* R, float alpha, int N, int K) {
    __shared__ float As[16][64 + 4];
    __shared__ float Bs[16][64 + 4];
    __shared__ float Bs2[MODE == 1 ? 16 : 1][64 + 4];
    const int tid = threadIdx.x, tx = tid & 15, ty = tid >> 4;
    const int m0 = blockIdx.y * 64, n0 = blockIdx.x * 64;
    float acc[4][4] = {}, acc2[4][4] = {};
    for (int k0 = 0; k0 < K; k0 += 16) {
        {
            const int r = tid >> 2, c4 = (tid & 3) * 4;
            const float4 a = *(const float4*)(A + (size_t)(m0 + r) * lda + k0 + c4);
            As[c4 + 0][r] = a.x; As[c4 + 1][r] = a.y; As[c4 + 2][r] = a.z; As[c4 + 3][r] = a.w;
        }
        {
            const int r = tid >> 4, c4 = (tid & 15) * 4;
#pragma unroll
            for (int i = 0; i < 4; ++i) { const int n = n0 + c4 + i; Bs[r][c4 + i] = (n < N) ? B[(size_t)(k0 + r) * ldb + n] : 0.f;
                if (MODE == 1) Bs2[r][c4 + i] = (n < N) ? B2[(size_t)(k0 + r) * ldb + n] : 0.f; }
        }
        __syncthreads();
#pragma unroll
        for (int k = 0; k < 16; ++k) {
            float a[4], b[4], b2[4];
#pragma unroll
            for (int i = 0; i < 4; ++i) { a[i] = As[k][ty * 4 + i]; b[i] = Bs[k][tx * 4 + i]; if (MODE == 1) b2[i] = Bs2[k][tx * 4 + i]; }
#pragma unroll
            for (int i = 0; i < 4; ++i)
#pragma unroll
                for (int j = 0; j < 4; ++j) { acc[i][j] += a[i] * b[j]; if (MODE == 1) acc2[i][j] += a[i] * b2[j]; }
        }
        __syncthreads();
    }
#pragma unroll
    for (int i = 0; i < 4; ++i)
#pragma unroll
        for (int j = 0; j < 4; ++j) {
            const int m = m0 + ty * 4 + i, n = n0 + tx * 4 + j;
            if (n < N) {
                float v = acc[i][j];
                if (MODE == 1) v = silu(v) * acc2[i][j];
                if (MODE == 2) v = R[(size_t)m * ldc + n] + alpha * v;
                C[(size_t)m * ldc + n] = v;
            }
        }
}

__global__ void __launch_bounds__(256) gdn_pre_k(const float* __restrict__ proj, const float* __restrict__ conv_w, const float* __restrict__ a_log, const float* __restrict__ dt_bias,
                                                 float* __restrict__ qkvc, float* __restrict__ gbuf, float* __restrict__ bbuf) {
    __shared__ float sums[12];
    const int t = blockIdx.x, tid = threadIdx.x;
    if (tid < 12) sums[tid] = 0.f;
    __syncthreads();
    float val[6];
#pragma unroll
    for (int i = 0; i < 6; ++i) {
        const int c = tid + 256 * i;
        float s = 0.f;
#pragma unroll
        for (int j = 0; j < CONVW; ++j) { const int tt = t + j - 2; if (tt >= 0 && tt < SEQ) s += proj[(size_t)tt * N_IN + C_QKVA + c] * conv_w[c * CONVW + j]; }
        val[i] = silu(s);
        if (c < 1024) atomicAdd(&sums[c >> 7], val[i] * val[i]);
    }
    __syncthreads();
#pragma unroll
    for (int i = 0; i < 6; ++i) {
        const int c = tid + 256 * i;
        float v = val[i];
        if (c < 1024) v *= rsqrtf(sums[c >> 7] + EPS);
        qkvc[(size_t)t * 1536 + c] = v;
    }
    if (tid < 8) {
        const float a = proj[(size_t)t * N_IN + C_A + tid] + dt_bias[tid];
        const float sp = (a > 20.f) ? a : log1pf(expf(a));
        gbuf[(size_t)tid * SEQ + t] = -expf(a_log[tid]) * sp;
        const float b = proj[(size_t)t * N_IN + C_B + tid];
        bbuf[(size_t)tid * SEQ + t] = 1.f / (1.f + expf(-b));
    }
}

__global__ void __launch_bounds__(1024) gdn_rec_k(const float* __restrict__ qkvc, const float* __restrict__ gbuf, const float* __restrict__ bbuf, float* __restrict__ o2) {
    const int dir = blockIdx.x >> 2, h = blockIdx.x & 3, tid = threadIdx.x, dv = tid >> 3, seg = tid & 7;
    float R[16];
#pragma unroll
    for (int i = 0; i < 16; ++i) R[i] = 0.f;
    const float* gp = gbuf + (size_t)(dir * 4 + h) * SEQ; const float* bp = bbuf + (size_t)(dir * 4 + h) * SEQ;
    float* op = o2 + (size_t)dir * SEQ * GW;
    const float qs = 0.08838834764831845f;
    for (int s = 0; s < SEQ; ++s) {
        const int t = dir ? (SEQ - 1 - s) : s;
        const float* row = qkvc + (size_t)t * 1536;
        float k[16], q[16];
#pragma unroll
        for (int i = 0; i < 4; ++i) { const float4 kk = *(const float4*)(row + 512 + h * 128 + seg * 16 + 4 * i); k[4 * i] = kk.x; k[4 * i + 1] = kk.y; k[4 * i + 2] = kk.z; k[4 * i + 3] = kk.w;
            const float4 qq = *(const float4*)(row + h * 128 + seg * 16 + 4 * i); q[4 * i] = qq.x; q[4 * i + 1] = qq.y; q[4 * i + 2] = qq.z; q[4 * i + 3] = qq.w; }
        const float v = row[1024 + h * 128 + dv];
        const float eg = expf(gp[t]), beta = bp[t];
        float p = 0.f;
#pragma unroll
        for (int i = 0; i < 16; ++i) p += R[i] * k[i];
        p += __shfl_xor(p, 1); p += __shfl_xor(p, 2); p += __shfl_xor(p, 4);
        const float delta = beta * (v - eg * p);
        float o = 0.f;
#pragma unroll
        for (int i = 0; i < 16; ++i) { R[i] = eg * R[i] + delta * k[i]; o += R[i] * q[i]; }
        o += __shfl_xor(o, 1); o += __shfl_xor(o, 2); o += __shfl_xor(o, 4);
        if (seg == 0) op[(size_t)t * GW + h * 128 + dv] = o * qs;
    }
}

__global__ void __launch_bounds__(512) gdn_post_k(const float* __restrict__ o2, const float* __restrict__ proj, const float* __restrict__ nw, float* __restrict__ mix) {
    __shared__ float sums[4];
    const int t = blockIdx.x, c = threadIdx.x;
    if (c < 4) sums[c] = 0.f;
    __syncthreads();
    const float o = o2[(size_t)t * GW + c] + o2[(size_t)SEQ * GW + (size_t)t * GW + c];
    atomicAdd(&sums[c >> 7], o * o);
    __syncthreads();
    const float z = proj[(size_t)t * N_IN + C_Z + c];
    mix[(size_t)t * D_MODEL + c] = o * rsqrtf(sums[c >> 7] * (1.f / 128.f) + EPS) * nw[c & 127] * silu(z);
}

__global__ void __launch_bounds__(256) qk_norm_k(float* __restrict__ proj, const float* __restrict__ qw, const float* __restrict__ kw) {
    const int gw = blockIdx.x * 4 + (threadIdx.x >> 6), lane = threadIdx.x & 63;
    const int t = gw >> 4, which = (gw >> 3) & 1, h = gw & 7;
    float* p = proj + (size_t)t * N_IN + C_QKVB + which * 512 + h * 64 + lane;
    const float v = *p;
    const float s = wave_sum(v * v);
    const float w = which ? kw[lane] : qw[lane] * 0.125f;
    *p = v * rsqrtf(s * (1.f / 64.f) + EPS) * w;
}

__global__ void __launch_bounds__(256) attn_k(const float* __restrict__ proj, const float* __restrict__ rel_bias, float* __restrict__ mix) {
    const int gw = blockIdx.x * 4 + (threadIdx.x >> 6), lane = threadIdx.x & 63;
    const int t = gw >> 3, h = gw & 7;
    const float* qp = proj + (size_t)t * N_IN + C_QKVB + h * 64;
    const float qv = qp[lane];
    float qa[64];
#pragma unroll
    for (int dd = 0; dd < 64; ++dd) qa[dd] = __shfl(qv, dd);
    float sc[7]; int pos[7];
    float mx = -1e30f;
#pragma unroll
    for (int r = 0; r < 7; ++r) {
        const int e = lane + 64 * r;
        float s = -1e30f; int kp = -1;
        if (e < 387) {
            const int p = e / 129, j = e % 129 - 64, d = (p == 0) ? 1 : (p == 1 ? 4 : 16);
            kp = t + d * j;
            if (kp >= 0 && kp < SEQ) {
                const float* kr = proj + (size_t)kp * N_IN + C_QKVB + 512 + h * 64;
                float a = 0.f;
#pragma unroll
                for (int dd = 0; dd < 64; ++dd) a += qa[dd] * kr[dd];
                s = a + rel_bias[(int)BUCKET[p][j + 64] * AH + h];
            } else kp = -1;
        }
        sc[r] = s; pos[r] = kp; mx = fmaxf(mx, s);
    }
    mx = wave_max(mx);
    float l = 0.f;
#pragma unroll
    for (int r = 0; r < 7; ++r) { sc[r] = (pos[r] >= 0) ? __expf(sc[r] - mx) : 0.f; l += sc[r]; }
    l = wave_sum(l);
    float o = 0.f;
#pragma unroll
    for (int r = 0; r < 7; ++r) {
        for (int src = 0; src < 64; ++src) {
            const float pe = __shfl(sc[r], src); const int kp = __shfl(pos[r], src);
            if (kp >= 0) o += pe * proj[(size_t)kp * N_IN + C_QKVB + 1024 + h * 64 + lane];
        }
    }
    mix[(size_t)t * D_MODEL + 512 + h * 64 + lane] = o / l;
}
}

extern "C" void kernel_launch(void* const* d_in, const int* in_sizes, int n_in, void* d_out, int out_size, void* d_ws, size_t ws_size, hipStream_t stream) {
    using namespace ref;
    const float* x = (const float*)d_in[0];
    const float* ffn1_norm = (const float*)d_in[1]; const float* w_g1 = (const float*)d_in[2]; const float* w_u1 = (const float*)d_in[3]; const float* w_d1 = (const float*)d_in[4];
    const float* mix_norm = (const float*)d_in[5]; const float* w_in = (const float*)d_in[6]; const float* conv_w = (const float*)d_in[7];
    const float* a_log = (const float*)d_in[8]; const float* dt_bias = (const float*)d_in[9]; const float* gdn_norm_w = (const float*)d_in[10];
    const float* q_norm_w = (const float*)d_in[11]; const float* k_norm_w = (const float*)d_in[12]; const float* rel_bias = (const float*)d_in[13];
    const float* w_out = (const float*)d_in[14]; const float* ffn2_norm = (const float*)d_in[15];
    const float* w_g2 = (const float*)d_in[16]; const float* w_u2 = (const float*)d_in[17]; const float* w_d2 = (const float*)d_in[18]; const float* final_norm = (const float*)d_in[19];
    float* out = (float*)d_out;
    char* ws = (char*)d_ws;
    const size_t MiB = 1u << 20;
    float* hbuf = (float*)(ws);
    float* abuf = (float*)(ws + 32 * MiB);
    float* qkvc = (float*)(ws + 150 * MiB);
    float* o2 = (float*)(ws + 200 * MiB);
    float* gbuf = (float*)(ws + 232 * MiB);
    float* bbuf = gbuf + 8 * SEQ;
    const int HR = SEQ;
    for (int hf = 0; hf < 2; ++hf) {
        const float* xin = x + (size_t)hf * HR * D_MODEL; float* xo = out + (size_t)hf * HR * D_MODEL;
        rmsnorm_k<<<HR / 4, 256, 0, stream>>>(xin, ffn1_norm, hbuf, HR);
        sgemm_k<1><<<dim3(D_FF / 64, HR / 64), 256, 0, stream>>>(hbuf, D_MODEL, w_g1, w_u1, D_FF, abuf, D_FF, nullptr, 0.f, D_FF, D_MODEL);
        sgemm_k<2><<<dim3(D_MODEL / 64, HR / 64), 256, 0, stream>>>(abuf, D_FF, w_d1, nullptr, D_MODEL, xo, D_MODEL, xin, 0.5f, D_MODEL, D_FF);
    }
    for (int b = 0; b < 2; ++b) {
        float* xb = out + (size_t)b * SEQ * D_MODEL;
        rmsnorm_k<<<SEQ / 4, 256, 0, stream>>>(xb, mix_norm, hbuf, SEQ);
        sgemm_k<0><<<dim3((N_IN + 63) / 64, SEQ / 64), 256, 0, stream>>>(hbuf, D_MODEL, w_in, nullptr, N_IN, abuf, N_IN, nullptr, 0.f, N_IN, D_MODEL);
        gdn_pre_k<<<SEQ, 256, 0, stream>>>(abuf, conv_w, a_log, dt_bias, qkvc, gbuf, bbuf);
        gdn_rec_k<<<8, 1024, 0, stream>>>(qkvc, gbuf, bbuf, o2);
        gdn_post_k<<<SEQ, 512, 0, stream>>>(o2, abuf, gdn_norm_w, hbuf);
        qk_norm_k<<<SEQ * 16 / 4, 256, 0, stream>>>(abuf, q_norm_w, k_norm_w);
        attn_k<<<SEQ * 8 / 4, 256, 0, stream>>>(abuf, rel_bias, hbuf);
        sgemm_k<2><<<dim3(D_MODEL / 64, SEQ / 64), 256, 0, stream>>>(hbuf, D_MODEL, w_out, nullptr, D_MODEL, xb, D_MODEL, xb, 1.0f, D_MODEL, D_MODEL);
    }
    for (int hf = 0; hf < 2; ++hf) {
        float* xo = out + (size_t)hf * HR * D_MODEL;
        rmsnorm_k<<<HR / 4, 256, 0, stream>>>(xo, ffn2_norm, hbuf, HR);
        sgemm_k<1><<<dim3(D_FF / 64, HR / 64), 256, 0, stream>>>(hbuf, D_MODEL, w_g2, w_u2, D_FF, abuf, D_FF, nullptr, 0.f, D_FF, D_MODEL);
        sgemm_k<2><<<dim3(D_MODEL / 64, HR / 64), 256, 0, stream>>>(abuf, D_FF, w_d2, nullptr, D_MODEL, xo, D_MODEL, xo, 0.5f, D_MODEL, D_FF);
        rmsnorm_k<<<HR / 4, 256, 0, stream>>>(xo, final_norm, xo, HR);
    }
}
```

```cpp
#include <hip/hip_runtime.h>
#include <cstdio>
#include <cstdint>
namespace pg8 {
#define PG8_LAS __attribute__((address_space(3)))
typedef unsigned short bf16_t;
typedef short bf16x8 __attribute__((ext_vector_type(8)));
typedef float f32x4 __attribute__((ext_vector_type(4)));
typedef unsigned u32x4 __attribute__((ext_vector_type(4)));
constexpr int BM = 256, BK = 64, HALF = 128, HTB = HALF * BK * 2  , STAGE_BYTES = 8 * HTB, NXCD = 8, WGM = 8;

__host__ __device__ __forceinline__ int lds_byte(int r, int c) { const int st = (r >> 4) * 2 + (c >> 5), rr = r & 15, cc = c & 31, ob = rr * 64 + cc * 2; return st * 1024 + (ob ^ (((ob >> 9) & 1) << 5)); }
__host__ __device__ __forceinline__ void stage_rc(int b, int& R, int& C) { const int st = b / 1024, sb = b % 1024, swz = sb ^ (((sb >> 9) & 1) << 5); R = (st >> 1) * 16 + swz / 64; C = (st & 1) * 32 + (swz % 64) / 2; }
__host__ __device__ __forceinline__ int perm32(int rho) { const int n = rho >> 4, i = rho & 15; return 8 * (i >> 2) + 4 * n + (i & 3); }

struct Unit { int pm, pn; };
struct Gemm { const bf16_t* A; const bf16_t* Bt; int M, N, K; };

struct StaticOrder {
    int nM, nN, nwg, G, c;
    __host__ __device__ void init(int M, int N, int G_, int c_) { nM = M / BM; nN = N / BM; nwg = nM * nN; G = G_; c = c_; }
    __host__ __device__ bool next(int i, Unit& u) const {
        const long L = (long)i * G + c; if (L >= nwg) return false;
        int wgid = (int)L; { const int q = nwg / NXCD, r = nwg % NXCD, xcd = wgid % NXCD, off = wgid / NXCD; wgid = (xcd < r ? xcd * (q + 1) : r * (q + 1) + (xcd - r) * q) + off; }
        const int nig = WGM * nN, gid = wgid / nig, fm = gid * WGM, gsz = (nM - fm) < WGM ? (nM - fm) : WGM;
        u.pm = fm + ((wgid % nig) % gsz); u.pn = (wgid % nig) / gsz; return true;
    }
    __device__ __forceinline__ void a_ready(const Unit&) const {}
    __device__ __forceinline__ void done(const Unit&) const {}
};

__device__ __forceinline__ unsigned cvt_pk_bf16(float lo, float hi) { unsigned r; asm volatile("v_cvt_pk_bf16_f32 %0, %1, %2" : "=v"(r) : "v"(lo), "v"(hi)); return r; }
__device__ __forceinline__ float fast_silu(float x) { return x * __builtin_amdgcn_rcpf(1.0f + __builtin_amdgcn_exp2f(-1.4426950408889634f * x)); }
constexpr float RMS_EPS = 1e-6f;

struct EpiSwiGLU {
    static constexpr bool PERM = true, AFTER_DRAIN = false;
    bf16_t* O; int ldc; const float* ss;
    __device__ __forceinline__ void operator()(const f32x4 (&acc)[2][2][4][2], const Unit& u, int wr, int wc, int fr, int fq) const {
        const int row0 = u.pm * BM + wr * 64 + fr, col0 = u.pn * HALF + wc * 32 + 8 * fq;
#pragma unroll
        for (int ai = 0; ai < 2; ++ai)
#pragma unroll
            for (int m = 0; m < 4; ++m) {
                const int row = row0 + ai * HALF + m * 16;
                const float r = rsqrtf(ss[row] * (1.0f / 1024.0f) + RMS_EPS);
                const f32x4 g0 = acc[ai][0][m][0] * r, g1 = acc[ai][0][m][1] * r, u0 = acc[ai][1][m][0] * r, u1 = acc[ai][1][m][1] * r;
                u32x4 w;
                w.x = cvt_pk_bf16(fast_silu(g0[0]) * u0[0], fast_silu(g0[1]) * u0[1]); w.y = cvt_pk_bf16(fast_silu(g0[2]) * u0[2], fast_silu(g0[3]) * u0[3]);
                w.z = cvt_pk_bf16(fast_silu(g1[0]) * u1[0], fast_silu(g1[1]) * u1[1]); w.w = cvt_pk_bf16(fast_silu(g1[2]) * u1[2], fast_silu(g1[3]) * u1[3]);
                *(u32x4*)(O + (size_t)row * ldc + col0) = w;
            }
    }
};
struct EpiResid {
    static constexpr bool PERM = true, AFTER_DRAIN = false;
    const float* base; float* out; bf16_t* xb; float* ss_out; float alpha;
    __device__ __forceinline__ void operator()(const f32x4 (&acc)[2][2][4][2], const Unit& u, int wr, int wc, int fr, int fq) const {
        const int row0 = u.pm * BM + wr * 64 + fr, col0 = u.pn * BM + wc * 32 + 8 * fq;
#pragma unroll
        for (int ai = 0; ai < 2; ++ai)
#pragma unroll
            for (int m = 0; m < 4; ++m) {
                const int row = row0 + ai * HALF + m * 16; float s = 0.f;
#pragma unroll
                for (int bj = 0; bj < 2; ++bj) {
                    const size_t off = (size_t)row * 1024 + col0 + bj * HALF;
                    const f32x4 b0 = *(const f32x4*)(base + off), b1 = *(const f32x4*)(base + off + 4);
                    const f32x4 v0 = b0 + acc[ai][bj][m][0] * alpha, v1 = b1 + acc[ai][bj][m][1] * alpha;
                    *(f32x4*)(out + off) = v0; *(f32x4*)(out + off + 4) = v1;
                    if (xb) { u32x4 w; w.x = cvt_pk_bf16(v0[0], v0[1]); w.y = cvt_pk_bf16(v0[2], v0[3]); w.z = cvt_pk_bf16(v1[0], v1[1]); w.w = cvt_pk_bf16(v1[2], v1[3]); *(u32x4*)(xb + off) = w; }
                    s += (v0[0] * v0[0] + v0[1] * v0[1]) + (v0[2] * v0[2] + v0[3] * v0[3]) + (v1[0] * v1[0] + v1[1] * v1[1]) + (v1[2] * v1[2] + v1[3] * v1[3]);
                }
                if (ss_out) { s += __shfl_xor(s, 16); s += __shfl_xor(s, 32); if (fq == 0) atomicAdd(ss_out + row, s); }
            }
    }
};
struct EpiProj {
    static constexpr bool PERM = true, AFTER_DRAIN = false;
    bf16_t* qkva; bf16_t* qkvb; float* ab; const float* ss; const float* nwt;
    static constexpr size_t Z_OFF = (size_t)16384 * 1536, QKVB_STRIDE = (size_t)16384 * 512;
    __device__ __forceinline__ void operator()(const f32x4 (&acc)[2][2][4][2], const Unit& u, int wr, int wc, int fr, int fq) const {
        const int row0 = u.pm * BM + wr * 64 + fr, pn = u.pn;
        if (pn < 8) {
            bf16_t* dst = qkva + (pn < 6 ? (size_t)0 : Z_OFF); const int ld = pn < 6 ? 1536 : 512; const int col0 = (pn < 6 ? pn : pn - 6) * BM + wc * 32 + 8 * fq;
#pragma unroll
            for (int ai = 0; ai < 2; ++ai)
#pragma unroll
                for (int m = 0; m < 4; ++m) { const int row = row0 + ai * HALF + m * 16; const float r = rsqrtf(ss[row] * (1.0f / 1024.0f) + RMS_EPS);
#pragma unroll
                    for (int bj = 0; bj < 2; ++bj) { const f32x4 v0 = acc[ai][bj][m][0] * r, v1 = acc[ai][bj][m][1] * r;
                        u32x4 w; w.x = cvt_pk_bf16(v0[0], v0[1]); w.y = cvt_pk_bf16(v0[2], v0[3]); w.z = cvt_pk_bf16(v1[0], v1[1]); w.w = cvt_pk_bf16(v1[2], v1[3]);
                        *(u32x4*)(dst + (size_t)row * ld + col0 + bj * HALF) = w; } }
        } else if (pn < 14) {
            const int sec = (pn - 8) >> 1, head = 4 * ((pn - 8) & 1) + wc;
            bf16_t* dst = qkvb + (size_t)sec * QKVB_STRIDE;
            const float* nw = nwt + sec * 64;
            f32x4 wv[2][2];
#pragma unroll
            for (int bj = 0; bj < 2; ++bj)
#pragma unroll
                for (int n = 0; n < 2; ++n) wv[bj][n] = *(const f32x4*)(nw + 32 * bj + 8 * fq + 4 * n);
#pragma unroll
            for (int ai = 0; ai < 2; ++ai)
#pragma unroll
                for (int m = 0; m < 4; ++m) { const int row = row0 + ai * HALF + m * 16; const float r = rsqrtf(ss[row] * (1.0f / 1024.0f) + RMS_EPS);
                    f32x4 v[2][2]; float s = 0.f;
#pragma unroll
                    for (int bj = 0; bj < 2; ++bj)
#pragma unroll
                        for (int n = 0; n < 2; ++n) { v[bj][n] = acc[ai][bj][m][n] * r; s += (v[bj][n][0] * v[bj][n][0] + v[bj][n][1] * v[bj][n][1]) + (v[bj][n][2] * v[bj][n][2] + v[bj][n][3] * v[bj][n][3]); }
                    s += __shfl_xor(s, 16); s += __shfl_xor(s, 32);
                    const float rn = sec < 2 ? rsqrtf(s * (1.0f / 64.0f) + RMS_EPS) : 1.0f;
#pragma unroll
                    for (int bj = 0; bj < 2; ++bj) { const f32x4 v0 = v[bj][0] * wv[bj][0] * rn, v1 = v[bj][1] * wv[bj][1] * rn;
                        u32x4 w; w.x = cvt_pk_bf16(v0[0], v0[1]); w.y = cvt_pk_bf16(v0[2], v0[3]); w.z = cvt_pk_bf16(v1[0], v1[1]); w.w = cvt_pk_bf16(v1[2], v1[3]);
                        *(u32x4*)(dst + (size_t)row * 512 + head * 64 + 32 * bj + 8 * fq) = w; } }
        } else {
            if (wc == 0 && fq < 2) {
#pragma unroll
                for (int ai = 0; ai < 2; ++ai)
#pragma unroll
                    for (int m = 0; m < 4; ++m) { const int row = row0 + ai * HALF + m * 16; const float r = rsqrtf(ss[row] * (1.0f / 1024.0f) + RMS_EPS);
                        *(f32x4*)(ab + (size_t)row * 16 + 8 * fq) = acc[ai][0][m][0] * r; *(f32x4*)(ab + (size_t)row * 16 + 8 * fq + 4) = acc[ai][0][m][1] * r; }
            }
        }
    }
};

template <class Epi, class Sched, bool ALIGN_EPI = false, bool SP2 = false>
__device__ __forceinline__ void gemm_phase(PG8_LAS unsigned char* lds, const Gemm g, const Sched& S, const Epi& E) {
    const int tid = threadIdx.x, wid = __builtin_amdgcn_readfirstlane(tid >> 6), lane = tid & 63, wr = wid >> 2, wc = wid & 3, fr = lane & 15, fq = lane >> 4;
    const int K = g.K, nt = K / BK;
    unsigned voffA[2], voffB[2];
#pragma unroll
    for (int i = 0; i < 2; ++i) { int R, C; stage_rc(tid * 16 + i * 8192, R, C); const int Rb = Epi::PERM ? ((R & ~31) + perm32(R & 31)) : R;
        voffA[i] = (unsigned)(R * K + C) * 2u; voffB[i] = (unsigned)(Rb * K + C) * 2u; }
    const size_t kstep = (size_t)(BK * 2);
    const size_t hstep = (size_t)HALF * K * 2;
    const size_t tstep = 2 * hstep;
    const unsigned ldsw = (unsigned)wid * 1024u;
    const int aoff = lds_byte(wr * 64 + fr, fq * 8), boff = lds_byte(wc * 32 + fr, fq * 8);
#define PG8_SA(b, h) (((b) * 2 + (h)) * HTB)
#define PG8_SB(b, h) ((4 + (b) * 2 + (h)) * HTB)
#define PG8_STAGE(bufoff, gbase, voff) do { _Pragma("unroll") for (int _i = 0; _i < 2; ++_i) \
        __builtin_amdgcn_global_load_lds((const unsigned*)((const char*)(gbase) + (voff)[_i]), (PG8_LAS unsigned*)(lds + (bufoff) + ldsw + _i * 8192), 16, 0, 0); } while (0)
#define PG8_LDA(dst, b, h) do { _Pragma("unroll") for (int m = 0; m < 4; ++m) _Pragma("unroll") for (int k = 0; k < 2; ++k) dst[m][k] = *(const PG8_LAS bf16x8*)(lds + PG8_SA(b, h) + aoff + m * 2048 + k * 1024); } while (0)
#define PG8_LDB(dst, b, h) do { _Pragma("unroll") for (int n = 0; n < 2; ++n) _Pragma("unroll") for (int k = 0; k < 2; ++k) dst[n][k] = *(const PG8_LAS bf16x8*)(lds + PG8_SB(b, h) + boff + n * 2048 + k * 1024); } while (0)
#define PG8_MMA(ai, bj, At, Bt) do { __builtin_amdgcn_s_setprio(1); _Pragma("unroll") for (int m = 0; m < 4; ++m) _Pragma("unroll") for (int n = 0; n < 2; ++n) _Pragma("unroll") for (int k = 0; k < 2; ++k) \
        acc[ai][bj][m][n] = __builtin_amdgcn_mfma_f32_16x16x32_bf16(Bt[n][k], At[m][k], acc[ai][bj][m][n], 0, 0, 0); __builtin_amdgcn_s_setprio(0); } while (0)
#define PG8_WAIT_V(n) asm volatile("s_waitcnt vmcnt(" #n ")" ::: "memory")
#define PG8_WAIT_L(n) asm volatile("s_waitcnt lgkmcnt(" #n ")" ::: "memory")
#define PG8_BAR __builtin_amdgcn_s_barrier()
#define PG8_SCHED __builtin_amdgcn_sched_barrier(0)
    Unit cur, nxt; int ui = 0;
    if (!S.next(0, cur)) return;
    f32x4 acc[2][2][4][2];
#pragma unroll
    for (int a = 0; a < 2; ++a)
#pragma unroll
        for (int b = 0; b < 2; ++b)
#pragma unroll
            for (int m = 0; m < 4; ++m)
#pragma unroll
                for (int n = 0; n < 2; ++n) acc[a][b][m][n] = (f32x4){0.f, 0.f, 0.f, 0.f};
    bf16x8 At[4][2], B0[2][2], B1[2][2];
    const char* cA = (const char*)g.A + (size_t)cur.pm * tstep; const char* cB = (const char*)g.Bt + (size_t)cur.pn * tstep;
    S.a_ready(cur);
    if constexpr (SP2) {
        PG8_STAGE(PG8_SB(0, 0), cB, voffB); PG8_STAGE(PG8_SB(0, 1), cB + hstep, voffB); PG8_STAGE(PG8_SA(0, 0), cA, voffA); PG8_STAGE(PG8_SA(0, 1), cA + hstep, voffA);
        if (wr == 1) PG8_BAR;
        PG8_WAIT_V(2); PG8_BAR;
        PG8_STAGE(PG8_SB(1, 0), cB + kstep, voffB); PG8_STAGE(PG8_SA(1, 0), cA + kstep, voffA); PG8_STAGE(PG8_SB(1, 1), cB + hstep + kstep, voffB);
        PG8_WAIT_V(6); PG8_BAR;
    } else {
        PG8_STAGE(PG8_SB(0, 0), cB, voffB); PG8_STAGE(PG8_SA(0, 0), cA, voffA); PG8_STAGE(PG8_SB(0, 1), cB + hstep, voffB); PG8_STAGE(PG8_SA(0, 1), cA + hstep, voffA);
        if (wr == 1) PG8_BAR;
        PG8_WAIT_V(4); PG8_BAR;
        PG8_STAGE(PG8_SB(1, 0), cB + kstep, voffB); PG8_STAGE(PG8_SA(1, 0), cA + kstep, voffA); PG8_STAGE(PG8_SB(1, 1), cB + hstep + kstep, voffB);
        PG8_WAIT_V(6); PG8_BAR;
    }
    for (;;) {
        const bool has_next = S.next(ui + 1, nxt);
        const char* nA = has_next ? (const char*)g.A + (size_t)nxt.pm * tstep : cA; const char* nB = has_next ? (const char*)g.Bt + (size_t)nxt.pn * tstep : cB;
        for (int t = 0; t < nt; t += 2) {
            const bool last = (t == nt - 2);
            const char* a1 = cA + (size_t)(t + 1) * kstep;
            const char* a2 = last ? nA : cA + (size_t)(t + 2) * kstep; const char* b2 = last ? nB : cB + (size_t)(t + 2) * kstep;
            const char* a3 = a2 + kstep; const char* b3 = b2 + kstep;
            if (last && has_next) S.a_ready(nxt);
            if constexpr (SP2) {
            PG8_LDB(B0, 0, 0); PG8_LDB(B1, 0, 1); PG8_SCHED; PG8_LDA(At, 0, 0); PG8_STAGE(PG8_SA(1, 1), a1 + hstep, voffA);
            PG8_WAIT_V(8); PG8_WAIT_L(0); PG8_BAR; PG8_MMA(0, 0, At, B0); PG8_MMA(0, 1, At, B1); PG8_BAR; PG8_SCHED;
            PG8_LDA(At, 0, 1); PG8_STAGE(PG8_SB(0, 0), b2, voffB); PG8_STAGE(PG8_SB(0, 1), b2 + hstep, voffB); PG8_STAGE(PG8_SA(0, 0), a2, voffA);
            PG8_WAIT_V(8); PG8_WAIT_L(0); PG8_BAR; PG8_MMA(1, 0, At, B0); PG8_MMA(1, 1, At, B1); PG8_BAR; PG8_SCHED;
            PG8_LDB(B0, 1, 0); PG8_LDB(B1, 1, 1); PG8_SCHED; PG8_LDA(At, 1, 0); PG8_STAGE(PG8_SA(0, 1), a2 + hstep, voffA);
            PG8_WAIT_V(8); PG8_WAIT_L(0); PG8_BAR; PG8_MMA(0, 0, At, B0); PG8_MMA(0, 1, At, B1); PG8_BAR; PG8_SCHED;
            PG8_LDA(At, 1, 1); PG8_STAGE(PG8_SB(1, 0), b3, voffB); PG8_STAGE(PG8_SB(1, 1), b3 + hstep, voffB); PG8_STAGE(PG8_SA(1, 0), a3, voffA);
            PG8_WAIT_V(8); PG8_WAIT_L(0); PG8_BAR; PG8_MMA(1, 0, At, B0); PG8_MMA(1, 1, At, B1); PG8_BAR; PG8_SCHED;
            } else {
            PG8_LDB(B0, 0, 0); PG8_SCHED; PG8_LDA(At, 0, 0); PG8_STAGE(PG8_SA(1, 1), a1 + hstep, voffA);
            PG8_WAIT_L(8); PG8_BAR; PG8_WAIT_L(0); PG8_MMA(0, 0, At, B0); PG8_BAR; PG8_SCHED;
            PG8_LDB(B1, 0, 1); PG8_STAGE(PG8_SB(0, 0), b2, voffB);
            PG8_BAR; PG8_WAIT_L(0); PG8_MMA(0, 1, At, B1); PG8_BAR;
            PG8_LDA(At, 0, 1); PG8_STAGE(PG8_SA(0, 0), a2, voffA);
            PG8_BAR; PG8_WAIT_L(0); PG8_MMA(1, 0, At, B0); PG8_BAR; PG8_SCHED;
            PG8_STAGE(PG8_SB(0, 1), b2 + hstep, voffB);
            PG8_WAIT_V(6); PG8_BAR; PG8_MMA(1, 1, At, B1); PG8_BAR;
            PG8_LDB(B0, 1, 0); PG8_SCHED; PG8_LDA(At, 1, 0); PG8_STAGE(PG8_SA(0, 1), a2 + hstep, voffA);
            PG8_WAIT_L(8); PG8_BAR; PG8_WAIT_L(0); PG8_MMA(0, 0, At, B0); PG8_BAR; PG8_SCHED;
            PG8_LDB(B1, 1, 1); PG8_STAGE(PG8_SB(1, 0), b3, voffB);
            PG8_BAR; PG8_WAIT_L(0); PG8_MMA(0, 1, At, B1); PG8_BAR;
            PG8_LDA(At, 1, 1); PG8_STAGE(PG8_SA(1, 0), a3, voffA);
            PG8_BAR; PG8_WAIT_L(0); PG8_MMA(1, 0, At, B0); PG8_BAR; PG8_SCHED;
            PG8_STAGE(PG8_SB(1, 1), b3 + hstep, voffB);
            PG8_WAIT_V(6); PG8_BAR; PG8_MMA(1, 1, At, B1); PG8_BAR;
            }
        }
        if constexpr (ALIGN_EPI) { if (wr == 0) PG8_BAR; }
        if constexpr (!Epi::AFTER_DRAIN) { E(acc, cur, wr, wc, fr, fq); S.done(cur); }
        if (!has_next) break;
#pragma unroll
        for (int a = 0; a < 2; ++a)
#pragma unroll
            for (int b = 0; b < 2; ++b)
#pragma unroll
                for (int m = 0; m < 4; ++m)
#pragma unroll
                    for (int n = 0; n < 2; ++n) acc[a][b][m][n] = (f32x4){0.f, 0.f, 0.f, 0.f};
        cur = nxt; cA = nA; cB = nB; ++ui;
        if constexpr (ALIGN_EPI) { if (wr == 1) PG8_BAR; }
    }
    PG8_WAIT_V(0);
    if constexpr (!ALIGN_EPI) { if (wr == 0) PG8_BAR; }
    PG8_BAR;
    if constexpr (Epi::AFTER_DRAIN) { E.fused(acc, cur, wr, wc, fr, fq, lds, wid, lane); S.done(cur); }
#undef PG8_SA
#undef PG8_SB
#undef PG8_STAGE
#undef PG8_LDA
#undef PG8_LDB
#undef PG8_MMA
#undef PG8_WAIT_V
#undef PG8_WAIT_L
#undef PG8_BAR
#undef PG8_SCHED
}
}
constexpr int NWAVES = 8;
constexpr int BATCH = 2, SEQ = 8192, D = 1024, FF = 2816, M = BATCH * SEQ;
constexpr int N_IN = 3600, NIN_PAD = 3840, NGU = 2 * FF;
constexpr int GH = 4, GD = 128, GW = 512, AH = 8, AD = 64, AW = 512;
constexpr float EPS = 1e-6f;
constexpr size_t MiB = 1u << 20;
constexpr size_t WS_CTL = 0, CTL_ZERO_BYTES = 1 * MiB;
constexpr size_t WS_SS2 = 256 * 1024, WS_SS3 = 320 * 1024, WS_SS4 = 384 * 1024;
constexpr size_t WS_SS1 = 1 * MiB, WS_NWT = 1 * MiB + 65536;
constexpr size_t WS_WGU1 = 2 * MiB, WS_WD1 = 13 * MiB, WS_WIN = 19 * MiB, WS_WOUT = 27 * MiB, WS_WGU2 = 29 * MiB, WS_WD2 = 40 * MiB;
constexpr size_t WS_XB = 46 * MiB, WS_XB2 = 78 * MiB;
constexpr size_t WS_ACT = 110 * MiB;
constexpr size_t WS_QKVA = 110 * MiB, WS_Z = 158 * MiB, WS_QB = 174 * MiB, WS_KB = 190 * MiB, WS_VB = 206 * MiB, WS_AB = 222 * MiB;
constexpr size_t WS_IF = 29 * MiB, WS_SCAL = 45 * MiB, WS_WF = WS_XB, WS_UC = WS_XB2, WS_QF = 223 * MiB, WS_KT = 239 * MiB;
constexpr size_t WS_END = 256 * MiB;
constexpr int CW_BAR = 4096;
constexpr int RING_OFF = 0, RING_BYTES = 131072;
constexpr int LDSCTL_OFF = RING_BYTES, MISC_OFF = LDSCTL_OFF + 320;
constexpr int LDS_BYTES = 147456;
#define GAS __attribute__((address_space(1)))
#define LAS __attribute__((address_space(3)))
typedef unsigned short bf16;
typedef unsigned v4u __attribute__((ext_vector_type(4)));
typedef float f32x4 __attribute__((ext_vector_type(4)));
typedef short bf16x8 __attribute__((ext_vector_type(8)));
typedef GAS unsigned gu32;
typedef GAS unsigned long long gu64;
#define RLX_AGENT __ATOMIC_RELAXED, __HIP_MEMORY_SCOPE_AGENT
#define LDS_WAIT() asm volatile("s_waitcnt lgkmcnt(0)" ::: "memory")
#define VM_WAIT() asm volatile("s_waitcnt vmcnt(0)" ::: "memory")
__device__ __forceinline__ unsigned long long rt() { return __builtin_amdgcn_s_memrealtime(); }
__device__ __forceinline__ unsigned f2bf(float f) { unsigned u = __builtin_bit_cast(unsigned, f); return (u + 0x7fffu + ((u >> 16) & 1u)) >> 16; }
__device__ __forceinline__ unsigned pk2(float lo, float hi) { return f2bf(lo) | (f2bf(hi) << 16); }

#define XB_TMO      128
#define XB_XCNT(j)  (256  + 64 * (j))
#define XB_XSUB(j)  (1280 + 64 * (j))
#define XB_XGEN(j)  (2304 + 64 * (j))
#define XB_TOP      3328
#define XB_TOPGEN   3392
#define XCD_BAR_WORDS 3456
#define XB_SPIN_CAP (1u << 18)

__device__ __forceinline__ unsigned xb_ld(unsigned* p)              { return __hip_atomic_load(p, __ATOMIC_RELAXED, __HIP_MEMORY_SCOPE_AGENT); }
__device__ __forceinline__ unsigned xb_add(unsigned* p, unsigned v) { return __hip_atomic_fetch_add(p, v, __ATOMIC_RELAXED, __HIP_MEMORY_SCOPE_AGENT); }
__device__ __forceinline__ unsigned xb_xcc_id() { return (unsigned)__builtin_amdgcn_s_getreg((3 << 11) | 20) & 0xFu; }
#define XB_SPIN(cond, bar) do { unsigned _sp = 0; while (cond) { __builtin_amdgcn_s_sleep(1); \
    if ((++_sp & 255u) == 0u) { if (xb_ld(&(bar)[XB_TMO])) break; if (_sp > XB_SPIN_CAP) { atomicAdd(&(bar)[XB_TMO], 1u); break; } } } } while (0)

struct XcdBarrier {
    unsigned* bar; unsigned x;
    volatile LAS unsigned* st;
};

__device__ __forceinline__ XcdBarrier xcd_barrier_post(unsigned* bar, volatile LAS unsigned* st) {
    XcdBarrier b; b.bar = bar; b.x = xb_xcc_id(); b.st = st;
    if (threadIdx.x == 0) (void)xb_add(&bar[XB_XCNT(b.x)], 1u);
    return b;
}
__device__ __forceinline__ void xcd_barrier_complete(unsigned* bar, unsigned x, unsigned& nloc, unsigned& nx) {
    const unsigned G = gridDim.x * gridDim.y * gridDim.z;
    unsigned sum, cnt, mine, sp = 0u;
    for (;;) {
        sum = 0u; cnt = 0u; mine = 0u;
#pragma unroll
        for (unsigned j = 0; j < 16; ++j) { const unsigned c = xb_ld(&bar[XB_XCNT(j)]); sum += c; cnt += (c > 0u) ? 1u : 0u; mine = (j == x) ? c : mine; }
        if (sum == G) break;
        __builtin_amdgcn_s_sleep(1);
        if ((++sp & 255u) == 0u) { if (xb_ld(&bar[XB_TMO])) break; if (sp > XB_SPIN_CAP) { atomicAdd(&bar[XB_TMO], 1u); break; } }
    }
    nloc = mine > 0u ? mine : 1u; nx = cnt > 0u ? cnt : 1u;
}

__device__ __forceinline__ void xcd_barrier(const XcdBarrier& b) {
    asm volatile("s_waitcnt vmcnt(0)" ::: "memory");
    __syncthreads();
    if (threadIdx.x == 0) {
        unsigned* bar = b.bar;
        __builtin_amdgcn_s_waitcnt(0);
        unsigned nloc = b.st[0], nx = b.st[1];
        if (nloc == 0u) { xcd_barrier_complete(bar, b.x, nloc, nx); b.st[0] = nloc; b.st[1] = nx; }
        const unsigned old = xb_add(&bar[XB_XSUB(b.x)], 1u);
        const unsigned gen = old / nloc;
        if (old + 1u == (gen + 1u) * nloc) {
            __builtin_amdgcn_fence(__ATOMIC_RELEASE, "agent");
            asm volatile("s_waitcnt vmcnt(0)" ::: "memory");
            const unsigned og = xb_add(&bar[XB_TOP], 1u);
            const unsigned tg = og / nx;
            if (og + 1u == (tg + 1u) * nx) xb_add(&bar[XB_TOPGEN], 1u);
            else XB_SPIN(xb_ld(&bar[XB_TOPGEN]) == tg, bar);
            __builtin_amdgcn_fence(__ATOMIC_ACQUIRE, "agent");
            xb_add(&bar[XB_XGEN(b.x)], 1u);
            asm volatile("s_waitcnt vmcnt(0)" ::: "memory");
        } else {
            XB_SPIN(xb_ld(&bar[XB_XGEN(b.x)]) == gen, bar);
            __builtin_amdgcn_fence(__ATOMIC_ACQUIRE, "agent");
            asm volatile("s_waitcnt vmcnt(0)" ::: "memory");
        }
    }
    __syncthreads();
}

struct Args { const float* in[20]; float* out; unsigned char* ws; int ph_lo, ph_hi, li, pad; };
enum { IN_X = 0, IN_FFN1_NORM, IN_WG1, IN_WU1, IN_WD1, IN_MIX_NORM, IN_WIN, IN_CONVW, IN_ALOG, IN_DTBIAS, IN_GDN_NORM, IN_QNORM, IN_KNORM, IN_RELBIAS, IN_WOUT, IN_FFN2_NORM, IN_WG2, IN_WU2, IN_WD2, IN_FINAL_NORM };
struct Frame {
    LAS unsigned char* lds; volatile LAS unsigned* MISC; gu32* ctl;
    int wave, vcu, G;
};
__device__ __forceinline__ float wave_sum(float v) {
#pragma unroll
    for (int o = 1; o < 64; o <<= 1) v += __shfl_xor(v, o);
    return v;
}
__device__ __forceinline__ float bf2f(unsigned short b) { return __builtin_bit_cast(float, (unsigned)b << 16); }

__device__ __forceinline__ void p0_transpose_item(const float* W, int ld, int k0, int n0, int nvalid, const float* scale, bf16* WT, int dstK, int row0, LAS float* scr, int lane) {
    const int c = lane & 31;
#pragma unroll 8
    for (int i = 0; i < 32; ++i) { const int kk = 2 * i + (lane >> 5); float v = (c < nvalid) ? W[(size_t)(k0 + kk) * ld + n0 + c] : 0.f; if (scale) v *= scale[k0 + kk]; scr[kk * 33 + c] = v; }
    LDS_WAIT(); asm volatile("" ::: "memory");
    const int ch = lane & 7;
#pragma unroll
    for (int j = 0; j < 4; ++j) { const int n = (lane >> 3) + 8 * j; const LAS float* s = scr + (8 * ch) * 33 + n;
        v4u o; o.x = pk2(s[0 * 33], s[1 * 33]); o.y = pk2(s[2 * 33], s[3 * 33]); o.z = pk2(s[4 * 33], s[5 * 33]); o.w = pk2(s[6 * 33], s[7 * 33]);
        *(GAS v4u*)(WT + (size_t)(row0 + n) * dstK + k0 + 8 * ch) = o; }
    LDS_WAIT(); asm volatile("" ::: "memory");
}
constexpr int I_GU = (D / 64) * (NGU / 32), I_D = (FF / 64) * (D / 32), I_IN = (D / 64) * (NIN_PAD / 32), I_OUT = (D / 64) * (D / 32);
__device__ __forceinline__ void p0_weight_item(const Args& a, int which, int r, LAS float* scr, int lane) {
    unsigned char* ws = a.ws;
    if (r < I_GU) { const int kb = r / (NGU / 32), nb = r % (NGU / 32), pn = nb >> 3, q = nb & 7;
        const float* src = which ? ((q >> 2) ? a.in[IN_WU2] : a.in[IN_WG2]) : ((q >> 2) ? a.in[IN_WU1] : a.in[IN_WG1]);
        p0_transpose_item(src, FF, 64 * kb, 128 * pn + 32 * (q & 3), 32, (which ? a.in[IN_FFN2_NORM] : a.in[IN_FFN1_NORM]), (bf16*)(ws + (which ? WS_WGU2 : WS_WGU1)), D, 32 * nb, scr, lane); return; }
    r -= I_GU;
    if (r < I_D) { const int kb = r / (D / 32), nb = r % (D / 32);
        p0_transpose_item((which ? a.in[IN_WD2] : a.in[IN_WD1]), D, 64 * kb, 32 * nb, 32, nullptr, (bf16*)(ws + (which ? WS_WD2 : WS_WD1)), FF, 32 * nb, scr, lane); return; }
    r -= I_D;
    if (r < I_IN) { const int kb = r / (NIN_PAD / 32), nb = r % (NIN_PAD / 32), pn = nb >> 3, q = nb & 7; int n0 = 32 * nb, nvalid = 32;
        if (pn >= 14) { n0 = 2048; nvalid = (q == 0) ? 16 : 0; }
        else if (pn >= 8) { const int sec = (pn - 8) >> 1, half = (pn - 8) & 1, bj = q >> 2, wc = q & 3; n0 = 2064 + sec * 512 + (4 * half + wc) * 64 + 32 * bj; }
        p0_transpose_item(a.in[IN_WIN], N_IN, 64 * kb, n0, nvalid, a.in[IN_MIX_NORM], (bf16*)(ws + WS_WIN), D, 32 * nb, scr, lane); return; }
    r -= I_IN;
    { const int kb = r / (D / 32), nb = r % (D / 32);
        p0_transpose_item(a.in[IN_WOUT], D, 64 * kb, 32 * nb, 32, nullptr, (bf16*)(ws + WS_WOUT), D, 32 * nb, scr, lane); }
}
__device__ __forceinline__ void x_row_to_bf16(const float* xrow, bf16* orow, float* ssp, int lane) {
    const GAS f32x4* xr = (const GAS f32x4*)xrow + lane;
    f32x4 v[4]; float s = 0.f;
#pragma unroll
    for (int j = 0; j < 4; ++j) { v[j] = xr[64 * j]; s += (v[j].x * v[j].x + v[j].y * v[j].y) + (v[j].z * v[j].z + v[j].w * v[j].w); }
    s = wave_sum(s);
    GAS unsigned long long* o8 = (GAS unsigned long long*)orow + lane;
#pragma unroll
    for (int j = 0; j < 4; ++j) o8[64 * j] = (unsigned long long)pk2(v[j].x, v[j].y) | ((unsigned long long)pk2(v[j].z, v[j].w) << 32);
    if (lane == 0) *ssp = s;
}
__device__ __forceinline__ void final_norm_row(float* row, const float* w, float ss, int lane) {
    const float r = rsqrtf(ss * (1.0f / D) + EPS);
    GAS f32x4* p = (GAS f32x4*)row + lane; const GAS f32x4* wp = (const GAS f32x4*)w + lane;
#pragma unroll
    for (int j = 0; j < 4; ++j) { f32x4 v = p[64 * j]; const f32x4 ww = wp[64 * j]; v = v * ww * r; p[64 * j] = v; }
}


namespace gdn {
typedef float f32x16 __attribute__((ext_vector_type(16)));
typedef float f32x4 __attribute__((ext_vector_type(4)));
typedef short bf16x8 __attribute__((ext_vector_type(8)));
typedef unsigned u32x4 __attribute__((ext_vector_type(4)));
typedef unsigned u32x2 __attribute__((ext_vector_type(2)));
constexpr int TS = 72;
constexpr int L_QS = 0, L_KS = 16384, L_KT = 32768, L_VT = 51200, L_LM = 69632, L_G = 106496, L_END = 108544;
constexpr int LM_BYTES = 18432;
typedef float f32x2_t __attribute__((ext_vector_type(2))); typedef __bf16 bf16x2_t __attribute__((ext_vector_type(2)));
__device__ __forceinline__ unsigned pkbf(float lo, float hi) { f32x2_t v = {lo, hi}; bf16x2_t b = __builtin_convertvector(v, bf16x2_t); return __builtin_bit_cast(unsigned, b); }
__device__ __forceinline__ bf16x8 pack8(const f32x16& x, int b) { u32x4 w; w.x = pkbf(x[b], x[b + 1]); w.y = pkbf(x[b + 2], x[b + 3]); w.z = pkbf(x[b + 4], x[b + 5]); w.w = pkbf(x[b + 6], x[b + 7]); return __builtin_bit_cast(bf16x8, w); }
__device__ __forceinline__ float lo2f(unsigned u) { return __builtin_bit_cast(float, u << 16); }
__device__ __forceinline__ float hi2f(unsigned u) { return __builtin_bit_cast(float, u & 0xffff0000u); }
__device__ __forceinline__ f32x16 mfma32(bf16x8 a, bf16x8 b, f32x16 c) { return __builtin_amdgcn_mfma_f32_32x32x16_bf16(a, b, c, 0, 0, 0); }
__device__ __forceinline__ int crow(int r, int hh) { return (r & 3) + 8 * (r >> 2) + 4 * hh; }
__device__ __forceinline__ int qk_off(int row, int d) { return row * 256 + ((((d >> 3) ^ (row & 15)) << 4) | ((d & 7) << 1)); }

struct Bufs { const bf16* qkva; const float* ab; bf16* Qf; bf16* Kt; bf16* Wf; bf16* If; bf16* Uc; float* Scal; unsigned* dbg; };
#ifdef GDN_DBG
#define DBGMAX(k, v) atomicMax(B.dbg + (k), __float_as_uint(v) & 0x7fffffffu)
#else
#define DBGMAX(k, v) do {} while (0)
#endif

__device__ __forceinline__ void prep_item(LAS unsigned char* lds, const Bufs& B, const float* conv_w, const float* a_log, const float* dt_bias, int bh, int c, int wave, int lane_in) {
    int lane = lane_in; asm volatile("" : "+v"(lane));
    const int b = bh >> 2, h = bh & 3, t0 = 64 * c;
    {
        const bf16* src = B.qkva + (size_t)b * SEQ * 1536 + h * 128 + 2 * lane;
        float wq[3][2][5];
#pragma unroll
        for (int sec = 0; sec < 3; ++sec)
#pragma unroll
            for (int e = 0; e < 2; ++e)
#pragma unroll
                for (int j = 0; j < 5; ++j) wq[sec][e][j] = conv_w[(size_t)(sec * 512 + h * 128 + 2 * lane + e) * 5 + j];
        float xin[3][12][2];
#pragma unroll
        for (int rr = 0; rr < 12; ++rr) { const int t = t0 + 8 * wave - 2 + rr; const bool ok = (t >= 0) && (t < SEQ);
#pragma unroll
            for (int sec = 0; sec < 3; ++sec) { const unsigned u = ok ? *(const unsigned*)(src + (size_t)t * 1536 + sec * 512) : 0u; xin[sec][rr][0] = lo2f(u); xin[sec][rr][1] = hi2f(u); } }
        unsigned ktp[2][4], vtp[2][4];
#pragma unroll
        for (int i = 0; i < 8; ++i) {
            float o[3][2];
#pragma unroll
            for (int sec = 0; sec < 3; ++sec)
#pragma unroll
                for (int e = 0; e < 2; ++e) { float s = 0.f;
#pragma unroll
                    for (int j = 0; j < 5; ++j) s += xin[sec][i + j][e] * wq[sec][e][j];
                    o[sec][e] = s / (1.f + __expf(-s)); }
            const float sq = wave_sum(o[0][0] * o[0][0] + o[0][1] * o[0][1]), sk = wave_sum(o[1][0] * o[1][0] + o[1][1] * o[1][1]);
            const float rq = rsqrtf(sq + EPS) * 0.08838834764831845f, rk = rsqrtf(sk + EPS);
            const int row = 8 * wave + i;
            *(LAS unsigned*)(lds + L_QS + qk_off(row, 2 * lane)) = pkbf(o[0][0] * rq, o[0][1] * rq);
            const unsigned kp = pkbf(o[1][0] * rk, o[1][1] * rk), vp = pkbf(o[2][0], o[2][1]);
            *(LAS unsigned*)(lds + L_KS + qk_off(row, 2 * lane)) = kp;
            if (i & 1) { ktp[0][i >> 1] |= kp << 16; ktp[1][i >> 1] |= kp & 0xffff0000u; vtp[0][i >> 1] |= vp << 16; vtp[1][i >> 1] |= vp & 0xffff0000u; }
            else { ktp[0][i >> 1] = kp & 0xffffu; ktp[1][i >> 1] = kp >> 16; vtp[0][i >> 1] = vp & 0xffffu; vtp[1][i >> 1] = vp >> 16; }
        }
#pragma unroll
        for (int e = 0; e < 2; ++e) {
            *(LAS u32x4*)(lds + L_KT + ((2 * lane + e) * TS + 8 * wave) * 2) = (u32x4){ktp[e][0], ktp[e][1], ktp[e][2], ktp[e][3]};
            *(LAS u32x4*)(lds + L_VT + ((2 * lane + e) * TS + 8 * wave) * 2) = (u32x4){vtp[e][0], vtp[e][1], vtp[e][2], vtp[e][3]};
        }
    }
    if (wave < 2) {
        const int dir = wave, t = t0 + lane; const float* abr = B.ab + ((size_t)b * SEQ + t) * 16;
        const float a = abr[dir * 4 + h] + dt_bias[dir * 4 + h];
        const float sp = (a > 20.f) ? a : log1pf(expf(a));
        float G = -expf(a_log[dir * 4 + h]) * sp;
        const float beta = 1.f / (1.f + expf(-abr[8 + dir * 4 + h]));
        if (dir == 0) {
#pragma unroll
            for (int o = 1; o < 64; o <<= 1) { const float n = __shfl_up(G, o); if (lane >= o) G += n; }
        } else {
#pragma unroll
            for (int o = 1; o < 64; o <<= 1) { const float n = __shfl_down(G, o); if (lane + o < 64) G += n; }
        }
        const float Gl = __shfl(G, dir ? 0 : 63);
        LAS float* gs = (LAS float*)(lds + L_G) + dir * 256;
        gs[lane] = G; gs[64 + lane] = beta; gs[128 + lane] = __expf(G); gs[192 + lane] = __expf(Gl - G);
        float* sc = B.Scal + ((size_t)(bh * 2 + dir) * 128 + c) * 128;
        sc[lane] = __expf(G); sc[64 + lane] = __expf(Gl - G);
    }
    LDS_WAIT(); __syncthreads();
    {
        asm volatile("" : "+v"(lane)); const int r32 = lane & 31, hh = lane >> 5;
        const bool isKK = wave < 4; const int ta = (wave >> 1) & 1, tb = wave & 1;
        f32x16 acc = {};
#pragma unroll
        for (int ks = 0; ks < 8; ++ks) {
            const bf16x8 av = *(const LAS bf16x8*)(lds + L_KS + qk_off(32 * ta + r32, 16 * ks + 8 * hh));
            const bf16x8 bv = *(const LAS bf16x8*)(lds + (isKK ? L_KS : L_QS) + qk_off(32 * tb + r32, 16 * ks + 8 * hh));
            acc = mfma32(av, bv, acc);
        }
        const LAS float* g0 = (const LAS float*)(lds + L_G); const LAS float* g1 = g0 + 256;
        const int col = 32 * tb + r32;
        if (isKK) {
            const float G0j = g0[col], G1j = g1[col];
            LAS float* L0 = (LAS float*)(lds + L_LM); LAS float* L1 = (LAS float*)(lds + L_LM + LM_BYTES);
#pragma unroll
            for (int r = 0; r < 16; ++r) { const int i = 32 * ta + crow(r, hh);
                if (i > col) L0[i * TS + col] = g0[64 + i] * acc[r] * __expf(g0[i] - G0j);
                if (i < col) L1[(63 - i) * TS + (63 - col)] = g1[64 + i] * acc[r] * __expf(g1[i] - G1j); }
        } else {
            const float G0i = g0[col], G1i = g1[col];
            f32x16 v0, v1;
#pragma unroll
            for (int r = 0; r < 16; ++r) { const int j = 32 * ta + crow(r, hh);
                v0[r] = (col >= j) ? acc[r] * __expf(G0i - g0[j]) : 0.f;
                v1[r] = (col <= j) ? acc[r] * __expf(G1i - g1[j]) : 0.f; }
#pragma unroll
            for (int s = 0; s < 2; ++s) {
                *(bf16x8*)(B.If + ((((size_t)(bh * 2 + 0) * 128 + c) * 2 + tb) * 4 + 2 * ta + s) * 512 + lane * 8) = pack8(v0, 8 * s);
                *(bf16x8*)(B.If + ((((size_t)(bh * 2 + 1) * 128 + c) * 2 + tb) * 4 + 2 * ta + s) * 512 + lane * 8) = pack8(v1, 8 * s);
            }
        }
    }
    LDS_WAIT(); __syncthreads();
    {
        asm volatile("" : "+v"(lane));
        const int dir = wave >> 2, col = 16 * (wave & 3) + (lane >> 2), q = lane & 3;
        const LAS float* Lm = (const LAS float*)(lds + L_LM + dir * LM_BYTES);
        float T[16];
#pragma unroll
        for (int m = 0; m < 16; ++m) T[m] = 0.f;
        if (q == 0) T[0] = (col == 0) ? 1.f : 0.f;
#pragma unroll
        for (int p = 1; p < 64; ++p) {
            float a = 0.f;
#pragma unroll
            for (int m = 0; m < (p + 3) / 4; ++m) { float lv = Lm[p * TS + 4 * m + q]; if (4 * m + 3 >= p) lv = (4 * m + q < p) ? lv : 0.f; a -= lv * T[m]; }
            a += __shfl_xor(a, 1); a += __shfl_xor(a, 2);
            if (q == (p & 3)) T[p >> 2] = a + ((col == p) ? 1.f : 0.f);
        }
        const LAS float* gs = (const LAS float*)(lds + L_G) + dir * 256;
        const int j = dir ? 63 - col : col;
        const float bj = gs[64 + j], bej = bj * gs[128 + j];
        LDS_WAIT(); __syncthreads();
        LAS bf16* Tu = (LAS bf16*)(lds + L_LM + dir * LM_BYTES); LAS bf16* Tw = Tu + 64 * TS;
#pragma unroll
        for (int m = 0; m < 16; ++m) { const int p = 4 * m + q, i = dir ? 63 - p : p; Tu[i * TS + j] = (bf16)f2bf(T[m] * bj); Tw[i * TS + j] = (bf16)f2bf(T[m] * bej); }
    }
#pragma unroll 1
    for (int f = wave; f < 32; f += 8) {
        asm volatile("" : "+v"(lane)); const int r32 = lane & 31, hh = lane >> 5;
        const bool isK = f >= 16; const int ff = f & 15;
        if (!isK) { const int mt = ff >> 3, ks = ff & 7, row = 32 * mt + r32;
            const u32x2 lo = *(const LAS u32x2*)(lds + L_QS + qk_off(row, 16 * ks + 4 * hh)), hi = *(const LAS u32x2*)(lds + L_QS + qk_off(row, 16 * ks + 8 + 4 * hh));
            *(u32x4*)(B.Qf + ((((size_t)bh * 128 + c) * 2 + mt) * 8 + ks) * 512 + lane * 8) = (u32x4){lo.x, lo.y, hi.x, hi.y};
        } else { const int mt = ff >> 2, ks = ff & 3, row = 32 * mt + r32;
            const u32x2 lo = *(const LAS u32x2*)(lds + L_KT + (row * TS + 16 * ks + 4 * hh) * 2), hi = *(const LAS u32x2*)(lds + L_KT + (row * TS + 16 * ks + 8 + 4 * hh) * 2);
            *(u32x4*)(B.Kt + ((((size_t)bh * 128 + c) * 4 + mt) * 4 + ks) * 512 + lane * 8) = (u32x4){lo.x, lo.y, hi.x, hi.y};
        }
    }
    LDS_WAIT(); __syncthreads();
#pragma unroll 1
    for (int k4 = 0; k4 < 4; ++k4) {
        asm volatile("" : "+v"(lane)); const int r32 = lane & 31, hh = lane >> 5;
        const int tt = wave * 4 + k4, dir = tt >> 4, kind = (tt >> 3) & 1, idx = tt & 7;
        const LAS unsigned char* Tu = lds + L_LM + dir * LM_BYTES; const LAS unsigned char* Tw = Tu + 64 * TS * 2;
        const size_t SC = (size_t)(bh * 2 + dir) * 128 + c;
        f32x16 acc = {};
        if (kind == 0) { const int mt = idx >> 2, dvt = idx & 3;
#pragma unroll
            for (int ks = 0; ks < 4; ++ks) { const bf16x8 a_ = *(const LAS bf16x8*)(Tu + ((32 * mt + r32) * TS + 16 * ks + 8 * hh) * 2), b_ = *(const LAS bf16x8*)(lds + L_VT + ((32 * dvt + r32) * TS + 16 * ks + 8 * hh) * 2);
#ifdef GDN_DBG
                for (int e_ = 0; e_ < 8; ++e_) { DBGMAX(0, bf2f((unsigned short)a_[e_])); DBGMAX(1, bf2f((unsigned short)b_[e_])); }
#endif
                acc = mfma32(a_, b_, acc); }
#ifdef GDN_DBG
            for (int e_ = 0; e_ < 16; ++e_) DBGMAX(2, acc[e_]);
#endif
            bf16* dst = B.Uc + ((SC * 4 + dvt) * 2 + mt) * 1024 + lane * 16;
            *(bf16x8*)dst = pack8(acc, 0); *(bf16x8*)(dst + 8) = pack8(acc, 8);
        } else { const int mtk = idx >> 1, ti = idx & 1;
#pragma unroll
            for (int ks = 0; ks < 4; ++ks) acc = mfma32(*(const LAS bf16x8*)(lds + L_KT + ((32 * mtk + r32) * TS + 16 * ks + 8 * hh) * 2), *(const LAS bf16x8*)(Tw + ((32 * ti + r32) * TS + 16 * ks + 8 * hh) * 2), acc);
#pragma unroll
            for (int s = 0; s < 2; ++s) *(bf16x8*)(B.Wf + (((SC * 2 + ti) * 8) + 2 * mtk + s) * 512 + lane * 8) = pack8(acc, 8 * s);
        }
    }
    LDS_WAIT(); __syncthreads();
}

__device__ __forceinline__ void scan_wave(const Bufs& B, int sq, int sl, int lane_in) {
    const int bh = sq >> 1, dir = sq & 1; int lane = lane_in;
    f32x16 S[4] = {};
#pragma unroll 1
    for (int step = 0; step < 128; ++step) {
        asm volatile("" : "+v"(lane)); const int hh = lane >> 5;
        const int c = dir ? 127 - step : step;
        const size_t SC = (size_t)sq * 128 + c, bhc = (size_t)bh * 128 + c;
        const float* sc = B.Scal + SC * 128;
        const unsigned lo16 = (unsigned)lane * 16u;
        const char* wfb = (const char*)(B.Wf + SC * 8192); const char* qfb = (const char*)(B.Qf + bhc * 8192); const char* ifb = (const char*)(B.If + SC * 4096); const char* ktb = (const char*)(B.Kt + bhc * 8192);
        char* ucb = (char*)(B.Uc + (SC * 4 + sl) * 2048);
        f32x16 Pw[2] = {}, Pq[2] = {};
#pragma unroll
        for (int ks = 0; ks < 8; ++ks) {
            const bf16x8 sb = pack8(S[ks >> 1], 8 * (ks & 1));
#pragma unroll
            for (int mt = 0; mt < 2; ++mt) {
                Pw[mt] = mfma32(*(const bf16x8*)(wfb + (mt * 8 + ks) * 1024 + lo16), sb, Pw[mt]);
                Pq[mt] = mfma32(*(const bf16x8*)(qfb + (mt * 8 + ks) * 1024 + lo16), sb, Pq[mt]);
            }
            if ((ks & 1) == 1) asm volatile("" ::: "memory");
        }
        bf16x8 Vb[4], Vs[4];
#pragma unroll
        for (int mt = 0; mt < 2; ++mt) {
            const char* up = ucb + mt * 2048 + 2 * lo16;
            const u32x4 u0 = *(const u32x4*)up, u1 = *(const u32x4*)(up + 16);
            const unsigned uu[8] = {u0.x, u0.y, u0.z, u0.w, u1.x, u1.y, u1.z, u1.w};
            f32x16 vs;
#pragma unroll
            for (int g = 0; g < 4; ++g) {
                const f32x4 ek = *(const f32x4*)(sc + 64 + 32 * mt + 8 * g + 4 * hh);
#pragma unroll
                for (int e = 0; e < 4; ++e) { const int r = 4 * g + e; const float u = (r & 1) ? hi2f(uu[r >> 1]) : lo2f(uu[r >> 1]); Pw[mt][r] = u - Pw[mt][r]; vs[r] = Pw[mt][r] * ek[e]; }
            }
            Vb[2 * mt] = pack8(Pw[mt], 0); Vb[2 * mt + 1] = pack8(Pw[mt], 8); Vs[2 * mt] = pack8(vs, 0); Vs[2 * mt + 1] = pack8(vs, 8);
            asm volatile("" ::: "memory");
        }
#pragma unroll
        for (int mt = 0; mt < 2; ++mt) {
#pragma unroll
            for (int g = 0; g < 4; ++g) { const f32x4 eg = *(const f32x4*)(sc + 32 * mt + 8 * g + 4 * hh);
#pragma unroll
                for (int e = 0; e < 4; ++e) Pq[mt][4 * g + e] *= eg[e]; }
#pragma unroll
            for (int ks = 0; ks < 4; ++ks) Pq[mt] = mfma32(*(const bf16x8*)(ifb + (mt * 4 + ks) * 1024 + lo16), Vb[ks], Pq[mt]);
            char* up = ucb + mt * 2048 + 2 * lo16;
            *(bf16x8*)up = pack8(Pq[mt], 0); *(bf16x8*)(up + 16) = pack8(Pq[mt], 8);
            asm volatile("" ::: "memory");
        }
        const float a = sc[dir ? 0 : 63];
#pragma unroll
        for (int T = 0; T < 4; ++T) {
            S[T] = S[T] * a;
#pragma unroll
            for (int ks = 0; ks < 4; ++ks) S[T] = mfma32(*(const bf16x8*)(ktb + (T * 4 + ks) * 1024 + lo16), Vs[ks], S[T]);
            if (T & 1) asm volatile("" ::: "memory");
        }
    }
}

__device__ __forceinline__ void finalize_item(const Bufs& B, const bf16* Z, const float* nw, bf16* XBo, int item, int lane) {
    const int Tt = item & 1, c = (item >> 1) & 127, bh = item >> 8, b = bh >> 2, h = bh & 3, r32 = lane & 31, hh = lane >> 5;
    float o[4][16];
#pragma unroll
    for (int sl = 0; sl < 4; ++sl) {
        const bf16* p0 = B.Uc + ((((size_t)(bh * 2 + 0) * 128 + c) * 4 + sl) * 2 + Tt) * 1024 + lane * 16;
        const bf16* p1 = B.Uc + ((((size_t)(bh * 2 + 1) * 128 + c) * 4 + sl) * 2 + Tt) * 1024 + lane * 16;
        const u32x4 a0 = *(const u32x4*)p0, a1 = *(const u32x4*)(p0 + 8), b0 = *(const u32x4*)p1, b1 = *(const u32x4*)(p1 + 8);
        const unsigned ua[8] = {a0.x, a0.y, a0.z, a0.w, a1.x, a1.y, a1.z, a1.w}, ub[8] = {b0.x, b0.y, b0.z, b0.w, b1.x, b1.y, b1.z, b1.w};
#pragma unroll
        for (int r = 0; r < 16; ++r) o[sl][r] = ((r & 1) ? hi2f(ua[r >> 1]) : lo2f(ua[r >> 1])) + ((r & 1) ? hi2f(ub[r >> 1]) : lo2f(ub[r >> 1]));
    }
    float nwv[4];
#pragma unroll
    for (int sl = 0; sl < 4; ++sl) nwv[sl] = nw[32 * sl + r32];
    const size_t rowb = (size_t)b * SEQ + 64 * c + 32 * Tt + 4 * hh;
#pragma unroll
    for (int r = 0; r < 16; ++r) {
        float s = (o[0][r] * o[0][r] + o[1][r] * o[1][r]) + (o[2][r] * o[2][r] + o[3][r] * o[3][r]);
#pragma unroll
        for (int m = 1; m < 32; m <<= 1) s += __shfl_xor(s, m);
        const float rn = rsqrtf(s * (1.0f / 128.0f) + EPS);
        const size_t row = rowb + (r & 3) + 8 * (r >> 2);
        const bf16* zp = Z + row * 512 + h * 128 + r32; bf16* xp = XBo + row * D + h * 128 + r32;
#pragma unroll
        for (int sl = 0; sl < 4; ++sl) { const float z = bf2f(zp[32 * sl]); xp[32 * sl] = (bf16)f2bf(o[sl][r] * rn * nwv[sl] * (z / (1.f + __expf(-z)))); }
        if ((r & 1) == 1) asm volatile("" ::: "memory");
    }
}
}

constexpr int N_PHASES = 11;
__global__ void __launch_bounds__(NWAVES * 64, 2) mk_fwd(Args args) {
    extern __shared__ __attribute__((aligned(16))) unsigned char lds[];
    Frame F;
    F.lds = (LAS unsigned char*)lds; F.MISC = (volatile LAS unsigned*)(F.lds + MISC_OFF);
    F.wave = __builtin_amdgcn_readfirstlane((int)threadIdx.x >> 6);
    F.G = gridDim.x; { const int bx = blockIdx.x; F.vcu = (F.G % 8 == 0) ? (bx % 8) * (F.G / 8) + bx / 8 : bx; }
    unsigned char* ws = args.ws;
    F.ctl = (gu32*)(ws + WS_CTL);
    for (int u = (int)threadIdx.x; u < (LDS_BYTES - LDSCTL_OFF) / 4; u += NWAVES * 64) ((LAS unsigned*)(F.lds + LDSCTL_OFF))[u] = 0u;
    __syncthreads();
    XcdBarrier bar = xcd_barrier_post((unsigned*)(F.ctl + CW_BAR) + args.li * XCD_BAR_WORDS, F.MISC + 8);
    const int lo = args.ph_lo, hi = args.ph_hi;
#define IN(k) (lo <= (k) && (k) < hi)
#define SEAM(k) do { if (IN(k) && IN((k) + 1)) xcd_barrier(bar); } while (0)
    bf16* XB = (bf16*)(ws + WS_XB); bf16* XB2 = (bf16*)(ws + WS_XB2); bf16* ACT = (bf16*)(ws + WS_ACT);
    float* SS1 = (float*)(ws + WS_SS1); float* SS2 = (float*)(ws + WS_SS2); float* SS3 = (float*)(ws + WS_SS3); float* SS4 = (float*)(ws + WS_SS4);
    const int gw = F.vcu * NWAVES + F.wave, NGW = F.G * NWAVES;

    if (IN(0)) {
        LAS float* scr = (LAS float*)(F.lds + RING_OFF + F.wave * 16384);
        constexpr int NITEMS = I_GU + I_D + I_IN + I_OUT;
        for (int it = gw; it < NITEMS; it += NGW) p0_weight_item(args, 0, it, scr, (int)(threadIdx.x & 63));
        if (blockIdx.x == 0 && (int)threadIdx.x < 192) { float* nwt = (float*)(ws + WS_NWT); nwt[(int)threadIdx.x] = (int)threadIdx.x < 64 ? args.in[IN_QNORM][(int)threadIdx.x] * 0.125f : ((int)threadIdx.x < 128 ? args.in[IN_KNORM][(int)threadIdx.x - 64] : 1.0f); }
        for (int m = gw; m < M; m += NGW) x_row_to_bf16(args.in[IN_X] + (size_t)m * D, XB + (size_t)m * D, SS1 + m, (int)(threadIdx.x & 63));
    }
    SEAM(0);
    if (IN(1)) {
        pg8::Gemm g{XB, (const bf16*)(ws + WS_WGU1), M, NGU, D}; pg8::StaticOrder S; S.init(M, NGU, F.G, (int)blockIdx.x);
        pg8::EpiSwiGLU E{ACT, FF, SS1};
        pg8::gemm_phase<pg8::EpiSwiGLU, pg8::StaticOrder, true, true>(F.lds + RING_OFF, g, S, E);
    }
    SEAM(1);
    if (IN(2)) {
        pg8::Gemm g{ACT, (const bf16*)(ws + WS_WD1), M, D, FF}; pg8::StaticOrder S; S.init(M, D, F.G, (int)blockIdx.x);
        pg8::EpiResid E{args.in[IN_X], args.out, XB, SS2, 0.5f};
        pg8::gemm_phase<pg8::EpiResid, pg8::StaticOrder, true, true>(F.lds + RING_OFF, g, S, E);
    }
    SEAM(2);
    if (IN(3)) {
        pg8::Gemm g{XB, (const bf16*)(ws + WS_WIN), M, NIN_PAD, D}; pg8::StaticOrder S; S.init(M, NIN_PAD, F.G, (int)blockIdx.x);
        pg8::EpiProj E{(bf16*)(ws + WS_QKVA), (bf16*)(ws + WS_QB), (float*)(ws + WS_AB), SS2, (const float*)(ws + WS_NWT)};
        pg8::gemm_phase<pg8::EpiProj, pg8::StaticOrder, true, true>(F.lds + RING_OFF, g, S, E);
    }
    SEAM(3);
    const gdn::Bufs GB{(const bf16*)(ws + WS_QKVA), (const float*)(ws + WS_AB), (bf16*)(ws + WS_QF), (bf16*)(ws + WS_KT), (bf16*)(ws + WS_WF), (bf16*)(ws + WS_IF), (bf16*)(ws + WS_UC), (float*)(ws + WS_SCAL), (unsigned*)(ws + 208 * 1024)};
    if (IN(4)) {
        for (int it = blockIdx.x; it < 8 * 128; it += F.G) gdn::prep_item(F.lds + RING_OFF, GB, args.in[IN_CONVW], args.in[IN_ALOG], args.in[IN_DTBIAS], it >> 7, it & 127, F.wave, (int)(threadIdx.x & 63));
    }
    SEAM(4);
    if (IN(5)) {
        if (blockIdx.x < 16 && F.wave < 4) gdn::scan_wave(GB, (int)blockIdx.x, F.wave, (int)(threadIdx.x & 63));
    }
    SEAM(5);
    if (IN(6)) {
        for (int it = gw; it < 8 * 128 * 2; it += NGW) gdn::finalize_item(GB, (const bf16*)(ws + WS_Z), args.in[IN_GDN_NORM], XB, it, (int)(threadIdx.x & 63));
        LAS float* scr = (LAS float*)(F.lds + RING_OFF + F.wave * 16384);
        for (int it = gw; it < I_GU + I_D; it += NGW) p0_weight_item(args, 1, it, scr, (int)(threadIdx.x & 63));
    }
    SEAM(6);
    if (IN(7)) {
        pg8::Gemm g{XB, (const bf16*)(ws + WS_WOUT), M, D, D}; pg8::StaticOrder S; S.init(M, D, F.G, (int)blockIdx.x);
        pg8::EpiResid E{args.out, args.out, XB2, SS3, 1.0f};
        pg8::gemm_phase<pg8::EpiResid, pg8::StaticOrder, true, true>(F.lds + RING_OFF, g, S, E);
    }
    SEAM(7);
    if (IN(8)) {
        pg8::Gemm g{XB2, (const bf16*)(ws + WS_WGU2), M, NGU, D}; pg8::StaticOrder S; S.init(M, NGU, F.G, (int)blockIdx.x);
        pg8::EpiSwiGLU E{ACT, FF, SS3};
        pg8::gemm_phase<pg8::EpiSwiGLU, pg8::StaticOrder, true, true>(F.lds + RING_OFF, g, S, E);
    }
    SEAM(8);
    if (IN(9)) {
        pg8::Gemm g{ACT, (const bf16*)(ws + WS_WD2), M, D, FF}; pg8::StaticOrder S; S.init(M, D, F.G, (int)blockIdx.x);
        pg8::EpiResid E{args.out, args.out, nullptr, SS4, 0.5f};
        pg8::gemm_phase<pg8::EpiResid, pg8::StaticOrder, true, true>(F.lds + RING_OFF, g, S, E);
    }
    SEAM(9);
    if (IN(10)) {
        for (int m = gw; m < M; m += NGW) final_norm_row(args.out + (size_t)m * D, args.in[IN_FINAL_NORM], SS4[m], (int)(threadIdx.x & 63));
    }
#undef IN
#undef SEAM
}

namespace ref {
constexpr int CONVW = 5;
__device__ const unsigned char BUCKET[3][129] = {
 {11,11,11,11,11,11,11,11,11,11,11,11,11,11,11,10,10,10,10,10,10,10,10,10,10,10,10,10,10,10,10,10,10,10,10,10,10,10,9,9,9,9,9,9,9,9,9,9,9,9,8,8,8,8,8,8,8,7,6,5,4,3,2,1,0,17,18,19,20,21,22,23,24,24,24,24,24,24,24,25,25,25,25,25,25,25,25,25,25,25,25,26,26,26,26,26,26,26,26,26,26,26,26,26,26,26,26,26,26,26,26,26,26,26,27,27,27,27,27,27,27,27,27,27,27,27,27,27,27},
 {13,13,13,13,13,13,13,13,13,13,13,13,13,13,13,13,13,13,13,13,13,13,13,12,12,12,12,12,12,12,12,12,12,12,12,12,12,12,12,12,12,12,11,11,11,11,11,11,11,11,11,11,10,10,10,10,10,10,9,9,9,8,8,4,0,20,24,24,25,25,25,26,26,26,26,26,26,27,27,27,27,27,27,27,27,27,27,28,28,28,28,28,28,28,28,28,28,28,28,28,28,28,28,28,28,28,29,29,29,29,29,29,29,29,29,29,29,29,29,29,29,29,29,29,29,29,29,29,29},
 {15,15,15,15,15,15,15,15,15,15,15,15,15,15,15,15,15,15,15,15,15,15,15,15,15,15,15,15,15,15,14,14,14,14,14,14,14,14,14,14,14,14,14,14,14,13,13,13,13,13,13,13,13,13,12,12,12,12,12,11,11,10,10,9,0,25,26,26,27,27,28,28,28,28,28,29,29,29,29,29,29,29,29,29,30,30,30,30,30,30,30,30,30,30,30,30,30,30,30,31,31,31,31,31,31,31,31,31,31,31,31,31,31,31,31,31,31,31,31,31,31,31,31,31,31,31,31,31,31}};
__device__ __forceinline__ float wave_max(float v) {
#pragma unroll
    for (int o = 1; o < 64; o <<= 1) v = fmaxf(v, __shfl_xor(v, o));
    return v;
}
__device__ __forceinline__ float silu(float x) { return x / (1.f + __expf(-x)); }
__global__ void __launch_bounds__(256) gdn_pre_k(const bf16* __restrict__ qkva, const float* __restrict__ ab, const float* __restrict__ conv_w, const float* __restrict__ a_log, const float* __restrict__ dt_bias,
                                                 bf16* __restrict__ qkvc, float* __restrict__ gbuf, float* __restrict__ bbuf) {
    __shared__ float sums[12];
    const int t = blockIdx.x, tid = threadIdx.x;
    if (tid < 12) sums[tid] = 0.f;
    __syncthreads();
    float val[6];
#pragma unroll
    for (int i = 0; i < 6; ++i) {
        const int c = tid + 256 * i;
        float s = 0.f;
#pragma unroll
        for (int j = 0; j < CONVW; ++j) { const int tt = t + j - 2; if (tt >= 0 && tt < SEQ) s += bf2f(qkva[(size_t)tt * 1536 + c]) * conv_w[c * CONVW + j]; }
        val[i] = silu(s);
        if (c < 1024) atomicAdd(&sums[c >> 7], val[i] * val[i]);
    }
    __syncthreads();
#pragma unroll
    for (int i = 0; i < 6; ++i) {
        const int c = tid + 256 * i;
        float v = val[i];
        if (c < 1024) v *= rsqrtf(sums[c >> 7] + EPS);
        qkvc[(size_t)t * 1536 + c] = (bf16)f2bf(v);
    }
    if (tid < 8) {
        const float a = ab[(size_t)t * 16 + tid] + dt_bias[tid];
        const float sp = (a > 20.f) ? a : log1pf(expf(a));
        gbuf[(size_t)tid * SEQ + t] = -expf(a_log[tid]) * sp;
        const float b = ab[(size_t)t * 16 + 8 + tid];
        bbuf[(size_t)tid * SEQ + t] = 1.f / (1.f + expf(-b));
    }
}
__global__ void __launch_bounds__(1024) gdn_rec_k(const bf16* __restrict__ qkvc, const float* __restrict__ gbuf, const float* __restrict__ bbuf, float* __restrict__ o2) {
    const int dir = blockIdx.x >> 2, h = blockIdx.x & 3, tid = threadIdx.x, dv = tid >> 3, seg = tid & 7;
    float R[16];
#pragma unroll
    for (int i = 0; i < 16; ++i) R[i] = 0.f;
    const float* gp = gbuf + (size_t)(dir * 4 + h) * SEQ; const float* bp = bbuf + (size_t)(dir * 4 + h) * SEQ;
    float* op = o2 + (size_t)dir * SEQ * GW;
    const float qs = 0.08838834764831845f;
    for (int s = 0; s < SEQ; ++s) {
        const int t = dir ? (SEQ - 1 - s) : s;
        const bf16* row = qkvc + (size_t)t * 1536;
        float k[16], q[16];
#pragma unroll
        for (int i = 0; i < 16; ++i) { k[i] = bf2f(row[512 + h * 128 + seg * 16 + i]); q[i] = bf2f(row[h * 128 + seg * 16 + i]); }
        const float v = bf2f(row[1024 + h * 128 + dv]);
        const float eg = expf(gp[t]), beta = bp[t];
        float p = 0.f;
#pragma unroll
        for (int i = 0; i < 16; ++i) p += R[i] * k[i];
        p += __shfl_xor(p, 1); p += __shfl_xor(p, 2); p += __shfl_xor(p, 4);
        const float delta = beta * (v - eg * p);
        float o = 0.f;
#pragma unroll
        for (int i = 0; i < 16; ++i) { R[i] = eg * R[i] + delta * k[i]; o += R[i] * q[i]; }
        o += __shfl_xor(o, 1); o += __shfl_xor(o, 2); o += __shfl_xor(o, 4);
        if (seg == 0) op[(size_t)t * GW + h * 128 + dv] = o * qs;
    }
}
__global__ void __launch_bounds__(512) gdn_post_k(const float* __restrict__ o2, const bf16* __restrict__ z, const float* __restrict__ nw, bf16* __restrict__ mix, int ldm) {
    __shared__ float sums[4];
    const int t = blockIdx.x, c = threadIdx.x;
    if (c < 4) sums[c] = 0.f;
    __syncthreads();
    const float o = o2[(size_t)t * GW + c] + o2[(size_t)SEQ * GW + (size_t)t * GW + c];
    atomicAdd(&sums[c >> 7], o * o);
    __syncthreads();
    mix[(size_t)t * ldm + c] = (bf16)f2bf(o * rsqrtf(sums[c >> 7] * (1.f / 128.f) + EPS) * nw[c & 127] * silu(bf2f(z[(size_t)t * 512 + c])));
}
__global__ void __launch_bounds__(256) attn_k(const bf16* __restrict__ qb, const bf16* __restrict__ kb, const bf16* __restrict__ vb, const float* __restrict__ rel_bias, bf16* __restrict__ mix) {
    const int gw = blockIdx.x * 4 + (threadIdx.x >> 6), lane = threadIdx.x & 63;
    const int t = gw >> 3, h = gw & 7;
    const float qv = bf2f(qb[(size_t)t * 512 + h * 64 + lane]);
    float qa[64];
#pragma unroll
    for (int dd = 0; dd < 64; ++dd) qa[dd] = __shfl(qv, dd);
    float sc[7]; int pos[7];
    float mx = -1e30f;
#pragma unroll
    for (int r = 0; r < 7; ++r) {
        const int e = lane + 64 * r;
        float s = -1e30f; int kp = -1;
        if (e < 387) {
            const int p = e / 129, j = e % 129 - 64, d = (p == 0) ? 1 : (p == 1 ? 4 : 16);
            kp = t + d * j;
            if (kp >= 0 && kp < SEQ) {
                const bf16* kr = kb + (size_t)kp * 512 + h * 64;
                float a = 0.f;
#pragma unroll
                for (int dd = 0; dd < 64; ++dd) a += qa[dd] * bf2f(kr[dd]);
                s = a + rel_bias[(int)BUCKET[p][j + 64] * AH + h];
            } else kp = -1;
        }
        sc[r] = s; pos[r] = kp; mx = fmaxf(mx, s);
    }
    mx = wave_max(mx);
    float l = 0.f;
#pragma unroll
    for (int r = 0; r < 7; ++r) { sc[r] = (pos[r] >= 0) ? __expf(sc[r] - mx) : 0.f; l += sc[r]; }
    l = wave_sum(l);
    float o = 0.f;
#pragma unroll
    for (int r = 0; r < 7; ++r) {
        for (int src = 0; src < 64; ++src) {
            const float pe = __shfl(sc[r], src); const int kp = __shfl(pos[r], src);
            if (kp >= 0) o += pe * bf2f(vb[(size_t)kp * 512 + h * 64 + lane]);
        }
    }
    mix[(size_t)t * D + 512 + h * 64 + lane] = (bf16)f2bf(o / l);
}
__global__ void __launch_bounds__(512) diff_k(bf16* mine, const bf16* refv, unsigned* maxbits) {
    const int t = blockIdx.x, c = threadIdx.x;
    const float a = bf2f(mine[(size_t)t * D + c]), r = bf2f(refv[(size_t)t * 512 + c]);
    float d = fabsf(a - r); if (!(d == d)) d = 7777.f;
    d = wave_max(d);
    if ((c & 63) == 0) atomicMax(maxbits, __float_as_uint(d));
    mine[(size_t)t * D + c] = refv[(size_t)t * 512 + c];
}
__global__ void poke_k(float* out, const unsigned* maxbits) { out[0] = 1000.f * __uint_as_float(*maxbits); }
__global__ void poke_code_k(float* out, const unsigned* code) { out[0] = 1000.f * (float)(*code); }
__global__ void __launch_bounds__(256) nanpos_bf16_k(const bf16* p, size_t n, unsigned* w) {
    unsigned cnt = 0, best = 0;
    for (size_t i = (size_t)blockIdx.x * 256 + threadIdx.x; i < n; i += (size_t)gridDim.x * 256) { if ((p[i] & 0x7f80u) == 0x7f80u) { ++cnt; const unsigned inv = 0xffffffffu - (unsigned)i; best = inv > best ? inv : best; } }
    if (cnt) { atomicAdd(w, cnt); atomicMax(w + 1, best); }
}
__global__ void poke_nanpos_k(float* out, const unsigned* w) {
    const unsigned cnt = w[0]; const unsigned idx = w[1] ? 0xffffffffu - w[1] : 0u;
    int lc = 0; for (unsigned c = cnt; c >= 10; c /= 10) ++lc;
#if NANPOS_MODE == 0
    const unsigned code = (lc > 9 ? 9 : lc) * 10 + ((idx >> 13) & 127) / 16;
#elif NANPOS_MODE == 1
    const unsigned code = ((idx >> 10) & 7) * 10 + ((idx & 15) >> 1);
#else
    const unsigned code = ((idx >> 4) & 63);
#endif
    out[0] = 1000.f * (float)code;
}
__global__ void poke_cat3_k(float* out, const unsigned* mx) {
    unsigned code = 0;
    for (int k = 2; k >= 0; --k) { const float v = __uint_as_float(mx[k]); int cat = (v != v) ? 3 : (v < 2.f ? 0 : (v < 1e4f ? 1 : 2)); code = code * 4 + cat; }
    out[0] = 1000.f * (float)code;
}
__global__ void poke_cat_k(float* out, const unsigned* mx) {
    unsigned code = 0;
    for (int k = 1; k >= 0; --k) { const float v = __uint_as_float(mx[k]); int cat = (v != v) ? 5 : (v < 10.f ? 0 : (v < 100.f ? 1 : (v < 1e4f ? 2 : (v < 1e10f ? 3 : 4)))); code = code * 6 + cat; }
    out[0] = 1000.f * (float)code;
}
__global__ void __launch_bounds__(256) maxabs_bf16_k(const bf16* p, size_t n, unsigned* mx) {
    unsigned best = 0;
    for (size_t i = (size_t)blockIdx.x * 256 + threadIdx.x; i < n; i += (size_t)gridDim.x * 256) { const unsigned b = ((unsigned)p[i] << 16) & 0x7fffffffu; best = b > best ? b : best; }
    atomicMax(mx, best);
}
__global__ void __launch_bounds__(256) chk_bf16_k(const bf16* p, size_t n, unsigned* code, unsigned bit) {
    bool bad = false;
    for (size_t i = (size_t)blockIdx.x * 256 + threadIdx.x; i < n; i += (size_t)gridDim.x * 256) { const float v = bf2f(p[i]); if (!(fabsf(v) < 1e4f)) bad = true; }
    if (__any(bad) && (threadIdx.x & 63) == 0) atomicOr(code, bit);
}
__global__ void __launch_bounds__(256) chk_f32_k(const float* p, size_t n, unsigned* code, unsigned bit) {
    bool bad = false;
    for (size_t i = (size_t)blockIdx.x * 256 + threadIdx.x; i < n; i += (size_t)gridDim.x * 256) { const float v = p[i]; if (!(fabsf(v) < 1e4f)) bad = true; }
    if (__any(bad) && (threadIdx.x & 63) == 0) atomicOr(code, bit);
}
}

extern "C" void kernel_launch(void* const* d_in, const int* in_sizes, int n_in, void* d_out, int out_size, void* d_ws, size_t ws_size, hipStream_t stream) {
    static int grid = 0;
    if (grid == 0) {
        if (n_in != 20 || in_sizes[0] != M * D || out_size != M * D || ws_size < WS_END) { fprintf(stderr, "kernel_launch: unexpected shapes (n_in %d, in0 %d, out %d, ws %zu)\n", n_in, n_in > 0 ? in_sizes[0] : -1, out_size, ws_size); grid = -1; return; }
        int dev = 0, cus = 0, per_cu = 0;
        if (hipGetDevice(&dev) != hipSuccess || hipDeviceGetAttribute(&cus, hipDeviceAttributeMultiprocessorCount, dev) != hipSuccess) { grid = -1; return; }
        if (hipFuncSetAttribute((const void*)mk_fwd, hipFuncAttributeMaxDynamicSharedMemorySize, LDS_BYTES) != hipSuccess) { fprintf(stderr, "kernel_launch: hipFuncSetAttribute failed\n"); grid = -1; return; }
        if (hipOccupancyMaxActiveBlocksPerMultiprocessor(&per_cu, (const void*)mk_fwd, NWAVES * 64, LDS_BYTES) != hipSuccess || per_cu < 1) { fprintf(stderr, "kernel_launch: occupancy query reports %d\n", per_cu); per_cu = 1; }
        (void)hipGetLastError();
        grid = cus;
    }
    if (grid < 0) return;
    unsigned char* ws = (unsigned char*)d_ws;
    (void)hipMemsetAsync(ws + WS_CTL, 0, CTL_ZERO_BYTES, stream);
    Args a{};
    for (int i = 0; i < 20; ++i) a.in[i] = (const float*)d_in[i];
    a.out = (float*)d_out; a.ws = ws;
#ifdef E3_CHECK
    a.ph_lo = 0; a.ph_hi = 5; a.li = 0;
    hipLaunchKernelGGL(mk_fwd, dim3(grid), dim3(NWAVES * 64), LDS_BYTES, stream, a);
    { unsigned* w = (unsigned*)(ws + 204 * 1024);
      ref::nanpos_bf16_k<<<2048, 256, 0, stream>>>((const bf16*)(ws + WS_UC), (size_t)16 << 20, w); }
    a.ph_lo = 5; a.ph_hi = 7; a.li = 2;
    hipLaunchKernelGGL(mk_fwd, dim3(grid), dim3(NWAVES * 64), LDS_BYTES, stream, a);
#else
    a.ph_lo = 0; a.ph_hi = 7; a.li = 0;
    hipLaunchKernelGGL(mk_fwd, dim3(grid), dim3(NWAVES * 64), LDS_BYTES, stream, a);
#endif
    {
        using namespace ref;
#ifdef E1_REF_GDN
        float* o2 = (float*)(ws + WS_XB2); float* gbuf = (float*)(ws + 223 * MiB); float* bbuf = gbuf + 8 * SEQ; bf16* qkvc = (bf16*)(ws + 224 * MiB); bf16* xbref = (bf16*)(ws + 248 * MiB);
        for (int b = 0; b < BATCH; ++b) {
            const size_t r0 = (size_t)b * SEQ;
            gdn_pre_k<<<SEQ, 256, 0, stream>>>((const bf16*)(ws + WS_QKVA) + r0 * 1536, (const float*)(ws + WS_AB) + r0 * 16, a.in[IN_CONVW], a.in[IN_ALOG], a.in[IN_DTBIAS], qkvc, gbuf, bbuf);
            gdn_rec_k<<<8, 1024, 0, stream>>>(qkvc, gbuf, bbuf, o2);
            gdn_post_k<<<SEQ, 512, 0, stream>>>(o2, (const bf16*)(ws + WS_Z) + r0 * 512, a.in[IN_GDN_NORM], xbref, 512);
            diff_k<<<SEQ, 512, 0, stream>>>((bf16*)(ws + WS_XB) + r0 * D, xbref, (unsigned*)(ws + 200 * 1024));
        }
#endif
        for (int b = 0; b < BATCH; ++b) {
            const size_t r0 = (size_t)b * SEQ;
            attn_k<<<SEQ * 8 / 4, 256, 0, stream>>>((const bf16*)(ws + WS_QB) + r0 * 512, (const bf16*)(ws + WS_KB) + r0 * 512, (const bf16*)(ws + WS_VB) + r0 * 512, a.in[IN_RELBIAS], (bf16*)(ws + WS_XB) + r0 * D);
        }
    }
    a.ph_lo = 7; a.ph_hi = 11; a.li = 1;
    hipLaunchKernelGGL(mk_fwd, dim3(grid), dim3(NWAVES * 64), LDS_BYTES, stream, a);
#ifdef E1_REF_GDN
#ifdef E3_CHECK
    ref::poke_nanpos_k<<<1, 1, 0, stream>>>((float*)d_out, (const unsigned*)(ws + 204 * 1024));
#else
    ref::poke_k<<<1, 1, 0, stream>>>((float*)d_out, (const unsigned*)(ws + 200 * 1024));
#endif
#endif
}
```

```cpp
#include <hip/hip_runtime.h>
#include <cstdio>
#include <cstdint>
namespace pg8 {
#define PG8_LAS __attribute__((address_space(3)))
typedef unsigned short bf16_t;
typedef short bf16x8 __attribute__((ext_vector_type(8)));
typedef float f32x4 __attribute__((ext_vector_type(4)));
typedef unsigned u32x4 __attribute__((ext_vector_type(4)));
constexpr int BM = 256, BK = 64, HALF = 128, HTB = HALF * BK * 2  , STAGE_BYTES = 8 * HTB, NXCD = 8, WGM = 8;

__host__ __device__ __forceinline__ int lds_byte(int r, int c) { const int st = (r >> 4) * 2 + (c >> 5), rr = r & 15, cc = c & 31, ob = rr * 64 + cc * 2; return st * 1024 + (ob ^ (((ob >> 9) & 1) << 5)); }
__host__ __device__ __forceinline__ void stage_rc(int b, int& R, int& C) { const int st = b / 1024, sb = b % 1024, swz = sb ^ (((sb >> 9) & 1) << 5); R = (st >> 1) * 16 + swz / 64; C = (st & 1) * 32 + (swz % 64) / 2; }
__host__ __device__ __forceinline__ int perm32(int rho) { const int n = rho >> 4, i = rho & 15; return 8 * (i >> 2) + 4 * n + (i & 3); }

struct Unit { int pm, pn; };
struct Gemm { const bf16_t* A; const bf16_t* Bt; int M, N, K; };

struct StaticOrder {
    int nM, nN, nwg, G, c;
    __host__ __device__ void init(int M, int N, int G_, int c_) { nM = M / BM; nN = N / BM; nwg = nM * nN; G = G_; c = c_; }
    __host__ __device__ bool next(int i, Unit& u) const {
        const long L = (long)i * G + c; if (L >= nwg) return false;
        int wgid = (int)L; { const int q = nwg / NXCD, r = nwg % NXCD, xcd = wgid % NXCD, off = wgid / NXCD; wgid = (xcd < r ? xcd * (q + 1) : r * (q + 1) + (xcd - r) * q) + off; }
        const int nig = WGM * nN, gid = wgid / nig, fm = gid * WGM, gsz = (nM - fm) < WGM ? (nM - fm) : WGM;
        u.pm = fm + ((wgid % nig) % gsz); u.pn = (wgid % nig) / gsz; return true;
    }
    __device__ __forceinline__ void a_ready(const Unit&) const {}
    __device__ __forceinline__ void done(const Unit&) const {}
};

__device__ __forceinline__ unsigned cvt_pk_bf16(float lo, float hi) { unsigned r; asm volatile("v_cvt_pk_bf16_f32 %0, %1, %2" : "=v"(r) : "v"(lo), "v"(hi)); return r; }
__device__ __forceinline__ float fast_silu(float x) { return x * __builtin_amdgcn_rcpf(1.0f + __builtin_amdgcn_exp2f(-1.4426950408889634f * x)); }
constexpr float RMS_EPS = 1e-6f;

struct EpiSwiGLU {
    static constexpr bool PERM = true, AFTER_DRAIN = false;
    bf16_t* O; int ldc; const float* ss;
    __device__ __forceinline__ void operator()(const f32x4 (&acc)[2][2][4][2], const Unit& u, int wr, int wc, int fr, int fq) const {
        const int row0 = u.pm * BM + wr * 64 + fr, col0 = u.pn * HALF + wc * 32 + 8 * fq;
#pragma unroll
        for (int ai = 0; ai < 2; ++ai)
#pragma unroll
            for (int m = 0; m < 4; ++m) {
                const int row = row0 + ai * HALF + m * 16;
                const float r = rsqrtf(ss[row] * (1.0f / 1024.0f) + RMS_EPS);
                const f32x4 g0 = acc[ai][0][m][0] * r, g1 = acc[ai][0][m][1] * r, u0 = acc[ai][1][m][0] * r, u1 = acc[ai][1][m][1] * r;
                u32x4 w;
                w.x = cvt_pk_bf16(fast_silu(g0[0]) * u0[0], fast_silu(g0[1]) * u0[1]); w.y = cvt_pk_bf16(fast_silu(g0[2]) * u0[2], fast_silu(g0[3]) * u0[3]);
                w.z = cvt_pk_bf16(fast_silu(g1[0]) * u1[0], fast_silu(g1[1]) * u1[1]); w.w = cvt_pk_bf16(fast_silu(g1[2]) * u1[2], fast_silu(g1[3]) * u1[3]);
                *(u32x4*)(O + (size_t)row * ldc + col0) = w;
            }
    }
};
struct EpiResid {
    static constexpr bool PERM = true, AFTER_DRAIN = false;
    const float* base; float* out; bf16_t* xb; float* ss_out; float alpha;
    __device__ __forceinline__ void operator()(const f32x4 (&acc)[2][2][4][2], const Unit& u, int wr, int wc, int fr, int fq) const {
        const int row0 = u.pm * BM + wr * 64 + fr, col0 = u.pn * BM + wc * 32 + 8 * fq;
#pragma unroll
        for (int ai = 0; ai < 2; ++ai)
#pragma unroll
            for (int m = 0; m < 4; ++m) {
                const int row = row0 + ai * HALF + m * 16; float s = 0.f;
#pragma unroll
                for (int bj = 0; bj < 2; ++bj) {
                    const size_t off = (size_t)row * 1024 + col0 + bj * HALF;
                    const f32x4 b0 = *(const f32x4*)(base + off), b1 = *(const f32x4*)(base + off + 4);
                    const f32x4 v0 = b0 + acc[ai][bj][m][0] * alpha, v1 = b1 + acc[ai][bj][m][1] * alpha;
                    *(f32x4*)(out + off) = v0; *(f32x4*)(out + off + 4) = v1;
                    if (xb) { u32x4 w; w.x = cvt_pk_bf16(v0[0], v0[1]); w.y = cvt_pk_bf16(v0[2], v0[3]); w.z = cvt_pk_bf16(v1[0], v1[1]); w.w = cvt_pk_bf16(v1[2], v1[3]); *(u32x4*)(xb + off) = w; }
                    s += (v0[0] * v0[0] + v0[1] * v0[1]) + (v0[2] * v0[2] + v0[3] * v0[3]) + (v1[0] * v1[0] + v1[1] * v1[1]) + (v1[2] * v1[2] + v1[3] * v1[3]);
                }
                if (ss_out) { s += __shfl_xor(s, 16); s += __shfl_xor(s, 32); if (fq == 0) atomicAdd(ss_out + row, s); }
            }
    }
};
struct EpiProj {
    static constexpr bool PERM = true, AFTER_DRAIN = false;
    bf16_t* qkva; bf16_t* qkvb; float* ab; const float* ss; const float* nwt;
    static constexpr size_t Z_OFF = (size_t)16384 * 1536, QKVB_STRIDE = (size_t)16384 * 512;
    __device__ __forceinline__ void operator()(const f32x4 (&acc)[2][2][4][2], const Unit& u, int wr, int wc, int fr, int fq) const {
        const int row0 = u.pm * BM + wr * 64 + fr, pn = u.pn;
        if (pn < 8) {
            bf16_t* dst = qkva + (pn < 6 ? (size_t)0 : Z_OFF); const int ld = pn < 6 ? 1536 : 512; const int col0 = (pn < 6 ? pn : pn - 6) * BM + wc * 32 + 8 * fq;
#pragma unroll
            for (int ai = 0; ai < 2; ++ai)
#pragma unroll
                for (int m = 0; m < 4; ++m) { const int row = row0 + ai * HALF + m * 16; const float r = rsqrtf(ss[row] * (1.0f / 1024.0f) + RMS_EPS);
#pragma unroll
                    for (int bj = 0; bj < 2; ++bj) { const f32x4 v0 = acc[ai][bj][m][0] * r, v1 = acc[ai][bj][m][1] * r;
                        u32x4 w; w.x = cvt_pk_bf16(v0[0], v0[1]); w.y = cvt_pk_bf16(v0[2], v0[3]); w.z = cvt_pk_bf16(v1[0], v1[1]); w.w = cvt_pk_bf16(v1[2], v1[3]);
                        *(u32x4*)(dst + (size_t)row * ld + col0 + bj * HALF) = w; } }
        } else if (pn < 14) {
            const int sec = (pn - 8) >> 1, head = 4 * ((pn - 8) & 1) + wc;
            bf16_t* dst = qkvb + (size_t)sec * QKVB_STRIDE;
            const float* nw = nwt + sec * 64;
            f32x4 wv[2][2];
#pragma unroll
            for (int bj = 0; bj < 2; ++bj)
#pragma unroll
                for (int n = 0; n < 2; ++n) wv[bj][n] = *(const f32x4*)(nw + 32 * bj + 8 * fq + 4 * n);
#pragma unroll
            for (int ai = 0; ai < 2; ++ai)
#pragma unroll
                for (int m = 0; m < 4; ++m) { const int row = row0 + ai * HALF + m * 16; const float r = rsqrtf(ss[row] * (1.0f / 1024.0f) + RMS_EPS);
                    f32x4 v[2][2]; float s = 0.f;
#pragma unroll
                    for (int bj = 0; bj < 2; ++bj)
#pragma unroll
                        for (int n = 0; n < 2; ++n) { v[bj][n] = acc[ai][bj][m][n] * r; s += (v[bj][n][0] * v[bj][n][0] + v[bj][n][1] * v[bj][n][1]) + (v[bj][n][2] * v[bj][n][2] + v[bj][n][3] * v[bj][n][3]); }
                    s += __shfl_xor(s, 16); s += __shfl_xor(s, 32);
                    const float rn = sec < 2 ? rsqrtf(s * (1.0f / 64.0f) + RMS_EPS) : 1.0f;
#pragma unroll
                    for (int bj = 0; bj < 2; ++bj) { const f32x4 v0 = v[bj][0] * wv[bj][0] * rn, v1 = v[bj][1] * wv[bj][1] * rn;
                        u32x4 w; w.x = cvt_pk_bf16(v0[0], v0[1]); w.y = cvt_pk_bf16(v0[2], v0[3]); w.z = cvt_pk_bf16(v1[0], v1[1]); w.w = cvt_pk_bf16(v1[2], v1[3]);
                        *(u32x4*)(dst + (size_t)row * 512 + head * 64 + 32 * bj + 8 * fq) = w; } }
        } else {
            if (wc == 0 && fq < 2) {
#pragma unroll
                for (int ai = 0; ai < 2; ++ai)
#pragma unroll
                    for (int m = 0; m < 4; ++m) { const int row = row0 + ai * HALF + m * 16; const float r = rsqrtf(ss[row] * (1.0f / 1024.0f) + RMS_EPS);
                        *(f32x4*)(ab + (size_t)row * 16 + 8 * fq) = acc[ai][0][m][0] * r; *(f32x4*)(ab + (size_t)row * 16 + 8 * fq + 4) = acc[ai][0][m][1] * r; }
            }
        }
    }
};

template <class Epi, class Sched, bool ALIGN_EPI = false, bool SP2 = false>
__device__ __forceinline__ void gemm_phase(PG8_LAS unsigned char* lds, const Gemm g, const Sched& S, const Epi& E) {
    const int tid = threadIdx.x, wid = __builtin_amdgcn_readfirstlane(tid >> 6), lane = tid & 63, wr = wid >> 2, wc = wid & 3, fr = lane & 15, fq = lane >> 4;
    const int K = g.K, nt = K / BK;
    unsigned voffA[2], voffB[2];
#pragma unroll
    for (int i = 0; i < 2; ++i) { int R, C; stage_rc(tid * 16 + i * 8192, R, C); const int Rb = Epi::PERM ? ((R & ~31) + perm32(R & 31)) : R;
        voffA[i] = (unsigned)(R * K + C) * 2u; voffB[i] = (unsigned)(Rb * K + C) * 2u; }
    const size_t kstep = (size_t)(BK * 2);
    const size_t hstep = (size_t)HALF * K * 2;
    const size_t tstep = 2 * hstep;
    const unsigned ldsw = (unsigned)wid * 1024u;
    const int aoff = lds_byte(wr * 64 + fr, fq * 8), boff = lds_byte(wc * 32 + fr, fq * 8);
#define PG8_SA(b, h) (((b) * 2 + (h)) * HTB)
#define PG8_SB(b, h) ((4 + (b) * 2 + (h)) * HTB)
#define PG8_STAGE(bufoff, gbase, voff) do { _Pragma("unroll") for (int _i = 0; _i < 2; ++_i) \
        __builtin_amdgcn_global_load_lds((const unsigned*)((const char*)(gbase) + (voff)[_i]), (PG8_LAS unsigned*)(lds + (bufoff) + ldsw + _i * 8192), 16, 0, 0); } while (0)
#define PG8_LDA(dst, b, h) do { _Pragma("unroll") for (int m = 0; m < 4; ++m) _Pragma("unroll") for (int k = 0; k < 2; ++k) dst[m][k] = *(const PG8_LAS bf16x8*)(lds + PG8_SA(b, h) + aoff + m * 2048 + k * 1024); } while (0)
#define PG8_LDB(dst, b, h) do { _Pragma("unroll") for (int n = 0; n < 2; ++n) _Pragma("unroll") for (int k = 0; k < 2; ++k) dst[n][k] = *(const PG8_LAS bf16x8*)(lds + PG8_SB(b, h) + boff + n * 2048 + k * 1024); } while (0)
#define PG8_MMA(ai, bj, At, Bt) do { __builtin_amdgcn_s_setprio(1); _Pragma("unroll") for (int m = 0; m < 4; ++m) _Pragma("unroll") for (int n = 0; n < 2; ++n) _Pragma("unroll") for (int k = 0; k < 2; ++k) \
        acc[ai][bj][m][n] = __builtin_amdgcn_mfma_f32_16x16x32_bf16(Bt[n][k], At[m][k], acc[ai][bj][m][n], 0, 0, 0); __builtin_amdgcn_s_setprio(0); } while (0)
#define PG8_WAIT_V(n) asm volatile("s_waitcnt vmcnt(" #n ")" ::: "memory")
#define PG8_WAIT_L(n) asm volatile("s_waitcnt lgkmcnt(" #n ")" ::: "memory")
#define PG8_BAR __builtin_amdgcn_s_barrier()
#define PG8_SCHED __builtin_amdgcn_sched_barrier(0)
    Unit cur, nxt; int ui = 0;
    if (!S.next(0, cur)) return;
    f32x4 acc[2][2][4][2];
#pragma unroll
    for (int a = 0; a < 2; ++a)
#pragma unroll
        for (int b = 0; b < 2; ++b)
#pragma unroll
            for (int m = 0; m < 4; ++m)
#pragma unroll
                for (int n = 0; n < 2; ++n) acc[a][b][m][n] = (f32x4){0.f, 0.f, 0.f, 0.f};
    bf16x8 At[4][2], B0[2][2], B1[2][2];
    const char* cA = (const char*)g.A + (size_t)cur.pm * tstep; const char* cB = (const char*)g.Bt + (size_t)cur.pn * tstep;
    S.a_ready(cur);
    if constexpr (SP2) {
        PG8_STAGE(PG8_SB(0, 0), cB, voffB); PG8_STAGE(PG8_SB(0, 1), cB + hstep, voffB); PG8_STAGE(PG8_SA(0, 0), cA, voffA); PG8_STAGE(PG8_SA(0, 1), cA + hstep, voffA);
        if (wr == 1) PG8_BAR;
        PG8_WAIT_V(2); PG8_BAR;
        PG8_STAGE(PG8_SB(1, 0), cB + kstep, voffB); PG8_STAGE(PG8_SA(1, 0), cA + kstep, voffA); PG8_STAGE(PG8_SB(1, 1), cB + hstep + kstep, voffB);
        PG8_WAIT_V(6); PG8_BAR;
    } else {
        PG8_STAGE(PG8_SB(0, 0), cB, voffB); PG8_STAGE(PG8_SA(0, 0), cA, voffA); PG8_STAGE(PG8_SB(0, 1), cB + hstep, voffB); PG8_STAGE(PG8_SA(0, 1), cA + hstep, voffA);
        if (wr == 1) PG8_BAR;
        PG8_WAIT_V(4); PG8_BAR;
        PG8_STAGE(PG8_SB(1, 0), cB + kstep, voffB); PG8_STAGE(PG8_SA(1, 0), cA + kstep, voffA); PG8_STAGE(PG8_SB(1, 1), cB + hstep + kstep, voffB);
        PG8_WAIT_V(6); PG8_BAR;
    }
    for (;;) {
        const bool has_next = S.next(ui + 1, nxt);
        const char* nA = has_next ? (const char*)g.A + (size_t)nxt.pm * tstep : cA; const char* nB = has_next ? (const char*)g.Bt + (size_t)nxt.pn * tstep : cB;
        for (int t = 0; t < nt; t += 2) {
            const bool last = (t == nt - 2);
            const char* a1 = cA + (size_t)(t + 1) * kstep;
            const char* a2 = last ? nA : cA + (size_t)(t + 2) * kstep; const char* b2 = last ? nB : cB + (size_t)(t + 2) * kstep;
            const char* a3 = a2 + kstep; const char* b3 = b2 + kstep;
            if (last && has_next) S.a_ready(nxt);
            if constexpr (SP2) {
            PG8_LDB(B0, 0, 0); PG8_LDB(B1, 0, 1); PG8_SCHED; PG8_LDA(At, 0, 0); PG8_STAGE(PG8_SA(1, 1), a1 + hstep, voffA);
            PG8_WAIT_V(8); PG8_WAIT_L(0); PG8_BAR; PG8_MMA(0, 0, At, B0); PG8_MMA(0, 1, At, B1); PG8_BAR; PG8_SCHED;
            PG8_LDA(At, 0, 1); PG8_STAGE(PG8_SB(0, 0), b2, voffB); PG8_STAGE(PG8_SB(0, 1), b2 + hstep, voffB); PG8_STAGE(PG8_SA(0, 0), a2, voffA);
            PG8_WAIT_V(8); PG8_WAIT_L(0); PG8_BAR; PG8_MMA(1, 0, At, B0); PG8_MMA(1, 1, At, B1); PG8_BAR; PG8_SCHED;
            PG8_LDB(B0, 1, 0); PG8_LDB(B1, 1, 1); PG8_SCHED; PG8_LDA(At, 1, 0); PG8_STAGE(PG8_SA(0, 1), a2 + hstep, voffA);
            PG8_WAIT_V(8); PG8_WAIT_L(0); PG8_BAR; PG8_MMA(0, 0, At, B0); PG8_MMA(0, 1, At, B1); PG8_BAR; PG8_SCHED;
            PG8_LDA(At, 1, 1); PG8_STAGE(PG8_SB(1, 0), b3, voffB); PG8_STAGE(PG8_SB(1, 1), b3 + hstep, voffB); PG8_STAGE(PG8_SA(1, 0), a3, voffA);
            PG8_WAIT_V(8); PG8_WAIT_L(0); PG8_BAR; PG8_MMA(1, 0, At, B0); PG8_MMA(1, 1, At, B1); PG8_BAR; PG8_SCHED;
            } else {
            PG8_LDB(B0, 0, 0); PG8_SCHED; PG8_LDA(At, 0, 0); PG8_STAGE(PG8_SA(1, 1), a1 + hstep, voffA);
            PG8_WAIT_L(8); PG8_BAR; PG8_WAIT_L(0); PG8_MMA(0, 0, At, B0); PG8_BAR; PG8_SCHED;
            PG8_LDB(B1, 0, 1); PG8_STAGE(PG8_SB(0, 0), b2, voffB);
            PG8_BAR; PG8_WAIT_L(0); PG8_MMA(0, 1, At, B1); PG8_BAR;
            PG8_LDA(At, 0, 1); PG8_STAGE(PG8_SA(0, 0), a2, voffA);
            PG8_BAR; PG8_WAIT_L(0); PG8_MMA(1, 0, At, B0); PG8_BAR; PG8_SCHED;
            PG8_STAGE(PG8_SB(0, 1), b2 + hstep, voffB);
            PG8_WAIT_V(6); PG8_BAR; PG8_MMA(1, 1, At, B1); PG8_BAR;
            PG8_LDB(B0, 1, 0); PG8_SCHED; PG8_LDA(At, 1, 0); PG8_STAGE(PG8_SA(0, 1), a2 + hstep, voffA);
            PG8_WAIT_L(8); PG8_BAR; PG8_WAIT_L(0); PG8_MMA(0, 0, At, B0); PG8_BAR; PG8_SCHED;
            PG8_LDB(B1, 1, 1); PG8_STAGE(PG8_SB(1, 0), b3, voffB);
            PG8_BAR; PG8_WAIT_L(0); PG8_MMA(0, 1, At, B1); PG8_BAR;
            PG8_LDA(At, 1, 1); PG8_STAGE(PG8_SA(1, 0), a3, voffA);
            PG8_BAR; PG8_WAIT_L(0); PG8_MMA(1, 0, At, B0); PG8_BAR; PG8_SCHED;
            PG8_STAGE(PG8_SB(1, 1), b3 + hstep, voffB);
            PG8_WAIT_V(6); PG8_BAR; PG8_MMA(1, 1, At, B1); PG8_BAR;
            }
        }
        if constexpr (ALIGN_EPI) { if (wr == 0) PG8_BAR; }
        if constexpr (!Epi::AFTER_DRAIN) { E(acc, cur, wr, wc, fr, fq); S.done(cur); }
        if (!has_next) break;
#pragma unroll
        for (int a = 0; a < 2; ++a)
#pragma unroll
            for (int b = 0; b < 2; ++b)
#pragma unroll
                for (int m = 0; m < 4; ++m)
#pragma unroll
                    for (int n = 0; n < 2; ++n) acc[a][b][m][n] = (f32x4){0.f, 0.f, 0.f, 0.f};
        cur = nxt; cA = nA; cB = nB; ++ui;
        if constexpr (ALIGN_EPI) { if (wr == 1) PG8_BAR; }
    }
    PG8_WAIT_V(0);
    if constexpr (!ALIGN_EPI) { if (wr == 0) PG8_BAR; }
    PG8_BAR;
    if constexpr (Epi::AFTER_DRAIN) { E.fused(acc, cur, wr, wc, fr, fq, lds, wid, lane); S.done(cur); }
#undef PG8_SA
#undef PG8_SB
#undef PG8_STAGE
#undef PG8_LDA
#undef PG8_LDB
#undef PG8_MMA
#undef PG8_WAIT_V
#undef PG8_WAIT_L
#undef PG8_BAR
#undef PG8_SCHED
}
}
constexpr int NWAVES = 8;
constexpr int BATCH = 2, SEQ = 8192, D = 1024, FF = 2816, M = BATCH * SEQ;
constexpr int N_IN = 3600, NIN_PAD = 3840, NGU = 2 * FF;
constexpr int GH = 4, GD = 128, GW = 512, AH = 8, AD = 64, AW = 512;
constexpr float EPS = 1e-6f;
constexpr size_t MiB = 1u << 20;
constexpr size_t WS_CTL = 0, CTL_ZERO_BYTES = 1 * MiB;
constexpr size_t WS_SS2 = 256 * 1024, WS_SS3 = 320 * 1024, WS_SS4 = 384 * 1024;
constexpr size_t WS_SS1 = 1 * MiB, WS_NWT = 1 * MiB + 65536;
constexpr size_t WS_WGU1 = 2 * MiB, WS_WD1 = 13 * MiB, WS_WIN = 19 * MiB, WS_WOUT = 27 * MiB, WS_WGU2 = 29 * MiB, WS_WD2 = 40 * MiB;
constexpr size_t WS_XB = 46 * MiB, WS_XB2 = 78 * MiB;
constexpr size_t WS_ACT = 110 * MiB;
constexpr size_t WS_QKVA = 110 * MiB, WS_Z = 158 * MiB, WS_QB = 174 * MiB, WS_KB = 190 * MiB, WS_VB = 206 * MiB, WS_AB = 222 * MiB;
constexpr size_t WS_IF = 29 * MiB, WS_SCAL = 45 * MiB, WS_WF = WS_XB, WS_UC = WS_XB2, WS_QF = 223 * MiB, WS_KT = 239 * MiB;
constexpr size_t WS_AO = WS_QKVA;
constexpr size_t WS_END = 256 * MiB;
constexpr int CW_BAR = 4096;
constexpr int RING_OFF = 0, RING_BYTES = 143360;
constexpr int LDSCTL_OFF = RING_BYTES, MISC_OFF = LDSCTL_OFF + 320;
constexpr int LDS_BYTES = 147456;
#define GAS __attribute__((address_space(1)))
#define LAS __attribute__((address_space(3)))
typedef unsigned short bf16;
typedef unsigned v4u __attribute__((ext_vector_type(4)));
typedef float f32x4 __attribute__((ext_vector_type(4)));
typedef short bf16x8 __attribute__((ext_vector_type(8)));
typedef GAS unsigned gu32;
typedef GAS unsigned long long gu64;
#define RLX_AGENT __ATOMIC_RELAXED, __HIP_MEMORY_SCOPE_AGENT
#define LDS_WAIT() asm volatile("s_waitcnt lgkmcnt(0)" ::: "memory")
#define VM_WAIT() asm volatile("s_waitcnt vmcnt(0)" ::: "memory")
__device__ __forceinline__ unsigned long long rt() { return __builtin_amdgcn_s_memrealtime(); }
__device__ __forceinline__ unsigned f2bf(float f) { unsigned u = __builtin_bit_cast(unsigned, f); return (u + 0x7fffu + ((u >> 16) & 1u)) >> 16; }
__device__ __forceinline__ unsigned pk2(float lo, float hi) { return f2bf(lo) | (f2bf(hi) << 16); }

#define XB_TMO      128
#define XB_XCNT(j)  (256  + 64 * (j))
#define XB_XSUB(j)  (1280 + 64 * (j))
#define XB_XGEN(j)  (2304 + 64 * (j))
#define XB_TOP      3328
#define XB_TOPGEN   3392
#define XCD_BAR_WORDS 3456
#define XB_SPIN_CAP (1u << 18)

__device__ __forceinline__ unsigned xb_ld(unsigned* p)              { return __hip_atomic_load(p, __ATOMIC_RELAXED, __HIP_MEMORY_SCOPE_AGENT); }
__device__ __forceinline__ unsigned xb_add(unsigned* p, unsigned v) { return __hip_atomic_fetch_add(p, v, __ATOMIC_RELAXED, __HIP_MEMORY_SCOPE_AGENT); }
__device__ __forceinline__ unsigned xb_xcc_id() { return (unsigned)__builtin_amdgcn_s_getreg((3 << 11) | 20) & 0xFu; }
#define XB_SPIN(cond, bar) do { unsigned _sp = 0; while (cond) { __builtin_amdgcn_s_sleep(1); \
    if ((++_sp & 255u) == 0u) { if (xb_ld(&(bar)[XB_TMO])) break; if (_sp > XB_SPIN_CAP) { atomicAdd(&(bar)[XB_TMO], 1u); break; } } } } while (0)

struct XcdBarrier {
    unsigned* bar; unsigned x;
    volatile LAS unsigned* st;
};

__device__ __forceinline__ XcdBarrier xcd_barrier_post(unsigned* bar, volatile LAS unsigned* st) {
    XcdBarrier b; b.bar = bar; b.x = xb_xcc_id(); b.st = st;
    if (threadIdx.x == 0) (void)xb_add(&bar[XB_XCNT(b.x)], 1u);
    return b;
}
__device__ __forceinline__ void xcd_barrier_complete(unsigned* bar, unsigned x, unsigned& nloc, unsigned& nx) {
    const unsigned G = gridDim.x * gridDim.y * gridDim.z;
    unsigned sum, cnt, mine, sp = 0u;
    for (;;) {
        sum = 0u; cnt = 0u; mine = 0u;
#pragma unroll
        for (unsigned j = 0; j < 16; ++j) { const unsigned c = xb_ld(&bar[XB_XCNT(j)]); sum += c; cnt += (c > 0u) ? 1u : 0u; mine = (j == x) ? c : mine; }
        if (sum == G) break;
        __builtin_amdgcn_s_sleep(1);
        if ((++sp & 255u) == 0u) { if (xb_ld(&bar[XB_TMO])) break; if (sp > XB_SPIN_CAP) { atomicAdd(&bar[XB_TMO], 1u); break; } }
    }
    nloc = mine > 0u ? mine : 1u; nx = cnt > 0u ? cnt : 1u;
}

__device__ __forceinline__ void xcd_barrier(const XcdBarrier& b) {
    asm volatile("s_waitcnt vmcnt(0)" ::: "memory");
    __syncthreads();
    if (threadIdx.x == 0) {
        unsigned* bar = b.bar;
        __builtin_amdgcn_s_waitcnt(0);
        unsigned nloc = b.st[0], nx = b.st[1];
        if (nloc == 0u) { xcd_barrier_complete(bar, b.x, nloc, nx); b.st[0] = nloc; b.st[1] = nx; }
        const unsigned old = xb_add(&bar[XB_XSUB(b.x)], 1u);
        const unsigned gen = old / nloc;
        if (old + 1u == (gen + 1u) * nloc) {
            __builtin_amdgcn_fence(__ATOMIC_RELEASE, "agent");
            asm volatile("s_waitcnt vmcnt(0)" ::: "memory");
            const unsigned og = xb_add(&bar[XB_TOP], 1u);
            const unsigned tg = og / nx;
            if (og + 1u == (tg + 1u) * nx) xb_add(&bar[XB_TOPGEN], 1u);
            else XB_SPIN(xb_ld(&bar[XB_TOPGEN]) == tg, bar);
            __builtin_amdgcn_fence(__ATOMIC_ACQUIRE, "agent");
            xb_add(&bar[XB_XGEN(b.x)], 1u);
            asm volatile("s_waitcnt vmcnt(0)" ::: "memory");
        } else {
            XB_SPIN(xb_ld(&bar[XB_XGEN(b.x)]) == gen, bar);
            __builtin_amdgcn_fence(__ATOMIC_ACQUIRE, "agent");
            asm volatile("s_waitcnt vmcnt(0)" ::: "memory");
        }
    }
    __syncthreads();
}

struct Args { const float* in[20]; float* out; unsigned char* ws; int ph_lo, ph_hi, li, pad; };
enum { IN_X = 0, IN_FFN1_NORM, IN_WG1, IN_WU1, IN_WD1, IN_MIX_NORM, IN_WIN, IN_CONVW, IN_ALOG, IN_DTBIAS, IN_GDN_NORM, IN_QNORM, IN_KNORM, IN_RELBIAS, IN_WOUT, IN_FFN2_NORM, IN_WG2, IN_WU2, IN_WD2, IN_FINAL_NORM };
struct Frame {
    LAS unsigned char* lds; volatile LAS unsigned* MISC; gu32* ctl;
    int wave, vcu, G;
};
__device__ __forceinline__ float wave_sum(float v) {
#pragma unroll
    for (int o = 1; o < 64; o <<= 1) v += __shfl_xor(v, o);
    return v;
}
__device__ __forceinline__ float bf2f(unsigned short b) { return __builtin_bit_cast(float, (unsigned)b << 16); }

__device__ __forceinline__ void p0_transpose_item(const float* W, int ld, int k0, int n0, int nvalid, const float* scale, bf16* WT, int dstK, int row0, LAS float* scr, int lane) {
    const int c = lane & 31;
#pragma unroll 8
    for (int i = 0; i < 32; ++i) { const int kk = 2 * i + (lane >> 5); float v = (c < nvalid) ? W[(size_t)(k0 + kk) * ld + n0 + c] : 0.f; if (scale) v *= scale[k0 + kk]; scr[kk * 33 + c] = v; }
    LDS_WAIT(); asm volatile("" ::: "memory");
    const int ch = lane & 7;
#pragma unroll
    for (int j = 0; j < 4; ++j) { const int n = (lane >> 3) + 8 * j; const LAS float* s = scr + (8 * ch) * 33 + n;
        v4u o; o.x = pk2(s[0 * 33], s[1 * 33]); o.y = pk2(s[2 * 33], s[3 * 33]); o.z = pk2(s[4 * 33], s[5 * 33]); o.w = pk2(s[6 * 33], s[7 * 33]);
        *(GAS v4u*)(WT + (size_t)(row0 + n) * dstK + k0 + 8 * ch) = o; }
    LDS_WAIT(); asm volatile("" ::: "memory");
}
constexpr int I_GU = (D / 64) * (NGU / 32), I_D = (FF / 64) * (D / 32), I_IN = (D / 64) * (NIN_PAD / 32), I_OUT = (D / 64) * (D / 32);
__device__ __forceinline__ void p0_weight_item(const Args& a, int which, int r, LAS float* scr, int lane) {
    unsigned char* ws = a.ws;
    if (r < I_GU) { const int kb = r / (NGU / 32), nb = r % (NGU / 32), pn = nb >> 3, q = nb & 7;
        const float* src = which ? ((q >> 2) ? a.in[IN_WU2] : a.in[IN_WG2]) : ((q >> 2) ? a.in[IN_WU1] : a.in[IN_WG1]);
        p0_transpose_item(src, FF, 64 * kb, 128 * pn + 32 * (q & 3), 32, (which ? a.in[IN_FFN2_NORM] : a.in[IN_FFN1_NORM]), (bf16*)(ws + (which ? WS_WGU2 : WS_WGU1)), D, 32 * nb, scr, lane); return; }
    r -= I_GU;
    if (r < I_D) { const int kb = r / (D / 32), nb = r % (D / 32);
        p0_transpose_item((which ? a.in[IN_WD2] : a.in[IN_WD1]), D, 64 * kb, 32 * nb, 32, nullptr, (bf16*)(ws + (which ? WS_WD2 : WS_WD1)), FF, 32 * nb, scr, lane); return; }
    r -= I_D;
    if (r < I_IN) { const int kb = r / (NIN_PAD / 32), nb = r % (NIN_PAD / 32), pn = nb >> 3, q = nb & 7; int n0 = 32 * nb, nvalid = 32;
        if (pn >= 14) { n0 = 2048; nvalid = (q == 0) ? 16 : 0; }
        else if (pn >= 8) { const int sec = (pn - 8) >> 1, half = (pn - 8) & 1, bj = q >> 2, wc = q & 3; n0 = 2064 + sec * 512 + (4 * half + wc) * 64 + 32 * bj; }
        p0_transpose_item(a.in[IN_WIN], N_IN, 64 * kb, n0, nvalid, a.in[IN_MIX_NORM], (bf16*)(ws + WS_WIN), D, 32 * nb, scr, lane); return; }
    r -= I_IN;
    { const int kb = r / (D / 32), nb = r % (D / 32);
        p0_transpose_item(a.in[IN_WOUT], D, 64 * kb, 32 * nb, 32, nullptr, (bf16*)(ws + WS_WOUT), D, 32 * nb, scr, lane); }
}
__device__ __forceinline__ void x_row_to_bf16(const float* xrow, bf16* orow, float* ssp, int lane) {
    const GAS f32x4* xr = (const GAS f32x4*)xrow + lane;
    f32x4 v[4]; float s = 0.f;
#pragma unroll
    for (int j = 0; j < 4; ++j) { v[j] = xr[64 * j]; s += (v[j].x * v[j].x + v[j].y * v[j].y) + (v[j].z * v[j].z + v[j].w * v[j].w); }
    s = wave_sum(s);
    GAS unsigned long long* o8 = (GAS unsigned long long*)orow + lane;
#pragma unroll
    for (int j = 0; j < 4; ++j) o8[64 * j] = (unsigned long long)pk2(v[j].x, v[j].y) | ((unsigned long long)pk2(v[j].z, v[j].w) << 32);
    if (lane == 0) *ssp = s;
}
__device__ __forceinline__ void final_norm_row(float* row, const float* w, float ss, int lane) {
    const float r = rsqrtf(ss * (1.0f / D) + EPS);
    GAS f32x4* p = (GAS f32x4*)row + lane; const GAS f32x4* wp = (const GAS f32x4*)w + lane;
#pragma unroll
    for (int j = 0; j < 4; ++j) { f32x4 v = p[64 * j]; const f32x4 ww = wp[64 * j]; v = v * ww * r; p[64 * j] = v; }
}


namespace gdn {
typedef float f32x16 __attribute__((ext_vector_type(16)));
typedef float f32x4 __attribute__((ext_vector_type(4)));
typedef short bf16x8 __attribute__((ext_vector_type(8)));
typedef unsigned u32x4 __attribute__((ext_vector_type(4)));
typedef unsigned u32x2 __attribute__((ext_vector_type(2)));
constexpr int TS = 72;
constexpr int L_QS = 0, L_KS = 16384, L_KT = 32768, L_VT = 51200, L_LM = 69632, L_G = 106496, L_END = 108544;
constexpr int LM_BYTES = 18432;
typedef float f32x2_t __attribute__((ext_vector_type(2))); typedef __bf16 bf16x2_t __attribute__((ext_vector_type(2)));
__device__ __forceinline__ unsigned pkbf(float lo, float hi) { f32x2_t v = {lo, hi}; bf16x2_t b = __builtin_convertvector(v, bf16x2_t); return __builtin_bit_cast(unsigned, b); }
__device__ __forceinline__ bf16x8 pack8(const f32x16& x, int b) { u32x4 w; w.x = pkbf(x[b], x[b + 1]); w.y = pkbf(x[b + 2], x[b + 3]); w.z = pkbf(x[b + 4], x[b + 5]); w.w = pkbf(x[b + 6], x[b + 7]); return __builtin_bit_cast(bf16x8, w); }
__device__ __forceinline__ float lo2f(unsigned u) { return __builtin_bit_cast(float, u << 16); }
__device__ __forceinline__ float hi2f(unsigned u) { return __builtin_bit_cast(float, u & 0xffff0000u); }
__device__ __forceinline__ f32x16 mfma32(bf16x8 a, bf16x8 b, f32x16 c) { return __builtin_amdgcn_mfma_f32_32x32x16_bf16(a, b, c, 0, 0, 0); }
__device__ __forceinline__ int crow(int r, int hh) { return (r & 3) + 8 * (r >> 2) + 4 * hh; }
__device__ __forceinline__ int qk_off(int row, int d) { return row * 256 + ((((d >> 3) ^ (row & 15)) << 4) | ((d & 7) << 1)); }

struct Bufs { const bf16* qkva; const float* ab; bf16* Qf; bf16* Kt; bf16* Wf; bf16* If; bf16* Uc; float* Scal; unsigned* dbg; };
#ifdef GDN_DBG
#define DBGMAX(k, v) atomicMax(B.dbg + (k), __float_as_uint(v) & 0x7fffffffu)
#else
#define DBGMAX(k, v) do {} while (0)
#endif

__device__ __forceinline__ void prep_item(LAS unsigned char* lds, const Bufs& B, const float* conv_w, const float* a_log, const float* dt_bias, int bh, int c, int wave, int lane_in) {
    int lane = lane_in; asm volatile("" : "+v"(lane));
    const int b = bh >> 2, h = bh & 3, t0 = 64 * c;
    {
        const bf16* src = B.qkva + (size_t)b * SEQ * 1536 + h * 128 + 2 * lane;
        float wq[3][2][5];
#pragma unroll
        for (int sec = 0; sec < 3; ++sec)
#pragma unroll
            for (int e = 0; e < 2; ++e)
#pragma unroll
                for (int j = 0; j < 5; ++j) wq[sec][e][j] = conv_w[(size_t)(sec * 512 + h * 128 + 2 * lane + e) * 5 + j];
        float xin[3][12][2];
#pragma unroll
        for (int rr = 0; rr < 12; ++rr) { const int t = t0 + 8 * wave - 2 + rr; const bool ok = (t >= 0) && (t < SEQ);
#pragma unroll
            for (int sec = 0; sec < 3; ++sec) { const unsigned u = ok ? *(const unsigned*)(src + (size_t)t * 1536 + sec * 512) : 0u; xin[sec][rr][0] = lo2f(u); xin[sec][rr][1] = hi2f(u); } }
        unsigned ktp[2][4], vtp[2][4];
#pragma unroll
        for (int i = 0; i < 8; ++i) {
            float o[3][2];
#pragma unroll
            for (int sec = 0; sec < 3; ++sec)
#pragma unroll
                for (int e = 0; e < 2; ++e) { float s = 0.f;
#pragma unroll
                    for (int j = 0; j < 5; ++j) s += xin[sec][i + j][e] * wq[sec][e][j];
                    o[sec][e] = s / (1.f + __expf(-s)); }
            const float sq = wave_sum(o[0][0] * o[0][0] + o[0][1] * o[0][1]), sk = wave_sum(o[1][0] * o[1][0] + o[1][1] * o[1][1]);
            const float rq = rsqrtf(sq + EPS) * 0.08838834764831845f, rk = rsqrtf(sk + EPS);
            const int row = 8 * wave + i;
            *(LAS unsigned*)(lds + L_QS + qk_off(row, 2 * lane)) = pkbf(o[0][0] * rq, o[0][1] * rq);
            const unsigned kp = pkbf(o[1][0] * rk, o[1][1] * rk), vp = pkbf(o[2][0], o[2][1]);
            *(LAS unsigned*)(lds + L_KS + qk_off(row, 2 * lane)) = kp;
            if (i & 1) { ktp[0][i >> 1] |= kp << 16; ktp[1][i >> 1] |= kp & 0xffff0000u; vtp[0][i >> 1] |= vp << 16; vtp[1][i >> 1] |= vp & 0xffff0000u; }
            else { ktp[0][i >> 1] = kp & 0xffffu; ktp[1][i >> 1] = kp >> 16; vtp[0][i >> 1] = vp & 0xffffu; vtp[1][i >> 1] = vp >> 16; }
        }
#pragma unroll
        for (int e = 0; e < 2; ++e) {
            *(LAS u32x4*)(lds + L_KT + ((2 * lane + e) * TS + 8 * wave) * 2) = (u32x4){ktp[e][0], ktp[e][1], ktp[e][2], ktp[e][3]};
            *(LAS u32x4*)(lds + L_VT + ((2 * lane + e) * TS + 8 * wave) * 2) = (u32x4){vtp[e][0], vtp[e][1], vtp[e][2], vtp[e][3]};
        }
    }
    if (wave < 2) {
        const int dir = wave, t = t0 + lane; const float* abr = B.ab + ((size_t)b * SEQ + t) * 16;
        const float a = abr[dir * 4 + h] + dt_bias[dir * 4 + h];
        const float sp = (a > 20.f) ? a : log1pf(expf(a));
        float G = -expf(a_log[dir * 4 + h]) * sp;
        const float beta = 1.f / (1.f + expf(-abr[8 + dir * 4 + h]));
        if (dir == 0) {
#pragma unroll
            for (int o = 1; o < 64; o <<= 1) { const float n = __shfl_up(G, o); if (lane >= o) G += n; }
        } else {
#pragma unroll
            for (int o = 1; o < 64; o <<= 1) { const float n = __shfl_down(G, o); if (lane + o < 64) G += n; }
        }
        const float Gl = __shfl(G, dir ? 0 : 63);
        LAS float* gs = (LAS float*)(lds + L_G) + dir * 256;
        gs[lane] = G; gs[64 + lane] = beta; gs[128 + lane] = __expf(G); gs[192 + lane] = __expf(Gl - G);
        float* sc = B.Scal + ((size_t)(bh * 2 + dir) * 128 + c) * 128;
        sc[lane] = __expf(G); sc[64 + lane] = __expf(Gl - G);
    }
    LDS_WAIT(); __syncthreads();
    {
        asm volatile("" : "+v"(lane)); const int r32 = lane & 31, hh = lane >> 5;
        const bool isKK = wave < 4; const int ta = (wave >> 1) & 1, tb = wave & 1;
        f32x16 acc = {};
#pragma unroll
        for (int ks = 0; ks < 8; ++ks) {
            const bf16x8 av = *(const LAS bf16x8*)(lds + L_KS + qk_off(32 * ta + r32, 16 * ks + 8 * hh));
            const bf16x8 bv = *(const LAS bf16x8*)(lds + (isKK ? L_KS : L_QS) + qk_off(32 * tb + r32, 16 * ks + 8 * hh));
            acc = mfma32(av, bv, acc);
        }
        const LAS float* g0 = (const LAS float*)(lds + L_G); const LAS float* g1 = g0 + 256;
        const int col = 32 * tb + r32;
        if (isKK) {
            const float G0j = g0[col], G1j = g1[col];
            LAS float* L0 = (LAS float*)(lds + L_LM); LAS float* L1 = (LAS float*)(lds + L_LM + LM_BYTES);
#pragma unroll
            for (int r = 0; r < 16; ++r) { const int i = 32 * ta + crow(r, hh);
                if (i > col) L0[i * TS + col] = g0[64 + i] * acc[r] * __expf(g0[i] - G0j);
                if (i < col) L1[(63 - i) * TS + (63 - col)] = g1[64 + i] * acc[r] * __expf(g1[i] - G1j); }
        } else {
            const float G0i = g0[col], G1i = g1[col];
            f32x16 v0, v1;
#pragma unroll
            for (int r = 0; r < 16; ++r) { const int j = 32 * ta + crow(r, hh);
                v0[r] = (col >= j) ? acc[r] * __expf(G0i - g0[j]) : 0.f;
                v1[r] = (col <= j) ? acc[r] * __expf(G1i - g1[j]) : 0.f; }
#pragma unroll
            for (int s = 0; s < 2; ++s) {
                *(bf16x8*)(B.If + ((((size_t)(bh * 2 + 0) * 128 + c) * 2 + tb) * 4 + 2 * ta + s) * 512 + lane * 8) = pack8(v0, 8 * s);
                *(bf16x8*)(B.If + ((((size_t)(bh * 2 + 1) * 128 + c) * 2 + tb) * 4 + 2 * ta + s) * 512 + lane * 8) = pack8(v1, 8 * s);
            }
        }
    }
    LDS_WAIT(); __syncthreads();
    {
        asm volatile("" : "+v"(lane));
        const int dir = wave >> 2, col = 16 * (wave & 3) + (lane >> 2), q = lane & 3;
        const LAS float* Lm = (const LAS float*)(lds + L_LM + dir * LM_BYTES);
        float T[16];
#pragma unroll
        for (int m = 0; m < 16; ++m) T[m] = 0.f;
        if (q == 0) T[0] = (col == 0) ? 1.f : 0.f;
#pragma unroll
        for (int p = 1; p < 64; ++p) {
            float a = 0.f;
#pragma unroll
            for (int m = 0; m < (p + 3) / 4; ++m) { float lv = Lm[p * TS + 4 * m + q]; if (4 * m + 3 >= p) lv = (4 * m + q < p) ? lv : 0.f; a -= lv * T[m]; }
            a += __shfl_xor(a, 1); a += __shfl_xor(a, 2);
            if (q == (p & 3)) T[p >> 2] = a + ((col == p) ? 1.f : 0.f);
        }
        const LAS float* gs = (const LAS float*)(lds + L_G) + dir * 256;
        const int j = dir ? 63 - col : col;
        const float bj = gs[64 + j], bej = bj * gs[128 + j];
        LDS_WAIT(); __syncthreads();
        LAS bf16* Tu = (LAS bf16*)(lds + L_LM + dir * LM_BYTES); LAS bf16* Tw = Tu + 64 * TS;
#pragma unroll
        for (int m = 0; m < 16; ++m) { const int p = 4 * m + q, i = dir ? 63 - p : p; Tu[i * TS + j] = (bf16)f2bf(T[m] * bj); Tw[i * TS + j] = (bf16)f2bf(T[m] * bej); }
    }
#pragma unroll 1
    for (int f = wave; f < 32; f += 8) {
        asm volatile("" : "+v"(lane)); const int r32 = lane & 31, hh = lane >> 5;
        const bool isK = f >= 16; const int ff = f & 15;
        if (!isK) { const int mt = ff >> 3, ks = ff & 7, row = 32 * mt + r32;
            const u32x2 lo = *(const LAS u32x2*)(lds + L_QS + qk_off(row, 16 * ks + 4 * hh)), hi = *(const LAS u32x2*)(lds + L_QS + qk_off(row, 16 * ks + 8 + 4 * hh));
            *(u32x4*)(B.Qf + ((((size_t)bh * 128 + c) * 2 + mt) * 8 + ks) * 512 + lane * 8) = (u32x4){lo.x, lo.y, hi.x, hi.y};
        } else { const int mt = ff >> 2, ks = ff & 3, row = 32 * mt + r32;
            const u32x2 lo = *(const LAS u32x2*)(lds + L_KT + (row * TS + 16 * ks + 4 * hh) * 2), hi = *(const LAS u32x2*)(lds + L_KT + (row * TS + 16 * ks + 8 + 4 * hh) * 2);
            *(u32x4*)(B.Kt + ((((size_t)bh * 128 + c) * 4 + mt) * 4 + ks) * 512 + lane * 8) = (u32x4){lo.x, lo.y, hi.x, hi.y};
        }
    }
    LDS_WAIT(); __syncthreads();
#pragma unroll 1
    for (int k4 = 0; k4 < 4; ++k4) {
        asm volatile("" : "+v"(lane)); const int r32 = lane & 31, hh = lane >> 5;
        const int tt = wave * 4 + k4, dir = tt >> 4, kind = (tt >> 3) & 1, idx = tt & 7;
        const LAS unsigned char* Tu = lds + L_LM + dir * LM_BYTES; const LAS unsigned char* Tw = Tu + 64 * TS * 2;
        const size_t SC = (size_t)(bh * 2 + dir) * 128 + c;
        f32x16 acc = {};
        if (kind == 0) { const int mt = idx >> 2, dvt = idx & 3;
#pragma unroll
            for (int ks = 0; ks < 4; ++ks) { const bf16x8 a_ = *(const LAS bf16x8*)(Tu + ((32 * mt + r32) * TS + 16 * ks + 8 * hh) * 2), b_ = *(const LAS bf16x8*)(lds + L_VT + ((32 * dvt + r32) * TS + 16 * ks + 8 * hh) * 2);
#ifdef GDN_DBG
                for (int e_ = 0; e_ < 8; ++e_) { DBGMAX(0, bf2f((unsigned short)a_[e_])); DBGMAX(1, bf2f((unsigned short)b_[e_])); }
#endif
                acc = mfma32(a_, b_, acc); }
#ifdef GDN_DBG
            for (int e_ = 0; e_ < 16; ++e_) DBGMAX(2, acc[e_]);
#endif
            bf16* dst = B.Uc + ((SC * 4 + dvt) * 2 + mt) * 1024 + lane * 16;
            *(bf16x8*)dst = pack8(acc, 0); *(bf16x8*)(dst + 8) = pack8(acc, 8);
        } else { const int mtk = idx >> 1, ti = idx & 1;
#pragma unroll
            for (int ks = 0; ks < 4; ++ks) acc = mfma32(*(const LAS bf16x8*)(lds + L_KT + ((32 * mtk + r32) * TS + 16 * ks + 8 * hh) * 2), *(const LAS bf16x8*)(Tw + ((32 * ti + r32) * TS + 16 * ks + 8 * hh) * 2), acc);
#pragma unroll
            for (int s = 0; s < 2; ++s) *(bf16x8*)(B.Wf + (((SC * 2 + ti) * 8) + 2 * mtk + s) * 512 + lane * 8) = pack8(acc, 8 * s);
        }
    }
    LDS_WAIT(); __syncthreads();
}

__device__ __forceinline__ void scan_wave(const Bufs& B, int sq, int sl, int lane_in) {
    const int bh = sq >> 1, dir = sq & 1; int lane = lane_in;
    f32x16 S[4] = {};
#pragma unroll 1
    for (int step = 0; step < 128; ++step) {
        asm volatile("" : "+v"(lane)); const int hh = lane >> 5;
        const int c = dir ? 127 - step : step;
        const size_t SC = (size_t)sq * 128 + c, bhc = (size_t)bh * 128 + c;
        const float* sc = B.Scal + SC * 128;
        const unsigned lo16 = (unsigned)lane * 16u;
        const char* wfb = (const char*)(B.Wf + SC * 8192); const char* qfb = (const char*)(B.Qf + bhc * 8192); const char* ifb = (const char*)(B.If + SC * 4096); const char* ktb = (const char*)(B.Kt + bhc * 8192);
        char* ucb = (char*)(B.Uc + (SC * 4 + sl) * 2048);
        f32x16 Pw[2] = {}, Pq[2] = {};
#pragma unroll
        for (int ks = 0; ks < 8; ++ks) {
            const bf16x8 sb = pack8(S[ks >> 1], 8 * (ks & 1));
#pragma unroll
            for (int mt = 0; mt < 2; ++mt) {
                Pw[mt] = mfma32(*(const bf16x8*)(wfb + (mt * 8 + ks) * 1024 + lo16), sb, Pw[mt]);
                Pq[mt] = mfma32(*(const bf16x8*)(qfb + (mt * 8 + ks) * 1024 + lo16), sb, Pq[mt]);
            }
            if ((ks & 1) == 1) { asm volatile("" ::: "memory"); __builtin_amdgcn_sched_barrier(0); }
        }
        bf16x8 Vb[4], Vs[4];
#pragma unroll
        for (int mt = 0; mt < 2; ++mt) {
            const char* up = ucb + mt * 2048 + 2 * lo16;
            const u32x4 u0 = *(const u32x4*)up, u1 = *(const u32x4*)(up + 16);
            const unsigned uu[8] = {u0.x, u0.y, u0.z, u0.w, u1.x, u1.y, u1.z, u1.w};
            f32x16 vs;
#pragma unroll
            for (int g = 0; g < 4; ++g) {
                const f32x4 ek = *(const f32x4*)(sc + 64 + 32 * mt + 8 * g + 4 * hh);
#pragma unroll
                for (int e = 0; e < 4; ++e) { const int r = 4 * g + e; const float u = (r & 1) ? hi2f(uu[r >> 1]) : lo2f(uu[r >> 1]); Pw[mt][r] = u - Pw[mt][r]; vs[r] = Pw[mt][r] * ek[e]; }
            }
            Vb[2 * mt] = pack8(Pw[mt], 0); Vb[2 * mt + 1] = pack8(Pw[mt], 8); Vs[2 * mt] = pack8(vs, 0); Vs[2 * mt + 1] = pack8(vs, 8);
            asm volatile("" ::: "memory"); __builtin_amdgcn_sched_barrier(0);
        }
#pragma unroll
        for (int mt = 0; mt < 2; ++mt) {
#pragma unroll
            for (int g = 0; g < 4; ++g) { const f32x4 eg = *(const f32x4*)(sc + 32 * mt + 8 * g + 4 * hh);
#pragma unroll
                for (int e = 0; e < 4; ++e) Pq[mt][4 * g + e] *= eg[e]; }
#pragma unroll
            for (int ks = 0; ks < 4; ++ks) Pq[mt] = mfma32(*(const bf16x8*)(ifb + (mt * 4 + ks) * 1024 + lo16), Vb[ks], Pq[mt]);
            char* up = ucb + mt * 2048 + 2 * lo16;
            *(bf16x8*)up = pack8(Pq[mt], 0); *(bf16x8*)(up + 16) = pack8(Pq[mt], 8);
            asm volatile("" ::: "memory"); __builtin_amdgcn_sched_barrier(0);
        }
        const float a = sc[dir ? 0 : 63];
#pragma unroll
        for (int T = 0; T < 4; ++T) {
            S[T] = S[T] * a;
#pragma unroll
            for (int ks = 0; ks < 4; ++ks) S[T] = mfma32(*(const bf16x8*)(ktb + (T * 4 + ks) * 1024 + lo16), Vs[ks], S[T]);
            if (T & 1) { asm volatile("" ::: "memory"); __builtin_amdgcn_sched_barrier(0); }
        }
    }
}

__device__ __forceinline__ void finalize_item(const Bufs& B, const bf16* Z, const float* nw, bf16* XBo, int item, int lane) {
    const int Tt = item & 1, c = (item >> 1) & 127, bh = item >> 8, b = bh >> 2, h = bh & 3, r32 = lane & 31, hh = lane >> 5;
    float o[4][16];
#pragma unroll
    for (int sl = 0; sl < 4; ++sl) {
        const bf16* p0 = B.Uc + ((((size_t)(bh * 2 + 0) * 128 + c) * 4 + sl) * 2 + Tt) * 1024 + lane * 16;
        const bf16* p1 = B.Uc + ((((size_t)(bh * 2 + 1) * 128 + c) * 4 + sl) * 2 + Tt) * 1024 + lane * 16;
        const u32x4 a0 = *(const u32x4*)p0, a1 = *(const u32x4*)(p0 + 8), b0 = *(const u32x4*)p1, b1 = *(const u32x4*)(p1 + 8);
        const unsigned ua[8] = {a0.x, a0.y, a0.z, a0.w, a1.x, a1.y, a1.z, a1.w}, ub[8] = {b0.x, b0.y, b0.z, b0.w, b1.x, b1.y, b1.z, b1.w};
#pragma unroll
        for (int r = 0; r < 16; ++r) o[sl][r] = ((r & 1) ? hi2f(ua[r >> 1]) : lo2f(ua[r >> 1])) + ((r & 1) ? hi2f(ub[r >> 1]) : lo2f(ub[r >> 1]));
    }
    float nwv[4];
#pragma unroll
    for (int sl = 0; sl < 4; ++sl) nwv[sl] = nw[32 * sl + r32];
    const size_t rowb = (size_t)b * SEQ + 64 * c + 32 * Tt + 4 * hh;
#pragma unroll
    for (int r = 0; r < 16; ++r) {
        float s = (o[0][r] * o[0][r] + o[1][r] * o[1][r]) + (o[2][r] * o[2][r] + o[3][r] * o[3][r]);
#pragma unroll
        for (int m = 1; m < 32; m <<= 1) s += __shfl_xor(s, m);
        const float rn = rsqrtf(s * (1.0f / 128.0f) + EPS);
        const size_t row = rowb + (r & 3) + 8 * (r >> 2);
        const bf16* zp = Z + row * 512 + h * 128 + r32; bf16* xp = XBo + row * D + h * 128 + r32;
#pragma unroll
        for (int sl = 0; sl < 4; ++sl) { const float z = bf2f(zp[32 * sl]); xp[32 * sl] = (bf16)f2bf(o[sl][r] * rn * nwv[sl] * (z / (1.f + __expf(-z)))); }
        if ((r & 1) == 1) asm volatile("" ::: "memory");
    }
}
}

namespace attn {
using gdn::f32x16; using gdn::bf16x8; using gdn::mfma32; using gdn::pack8; using gdn::crow; using gdn::f32x4; using gdn::u32x4;
typedef short s16x4 __attribute__((ext_vector_type(4)));
constexpr int A_OACC = 0, A_L = 65536, A_BIAS = 66560, A_V = 68608, A_END = A_V + 8 * 8192;
__device__ const unsigned char BUCKET[3][129] = {
 {11,11,11,11,11,11,11,11,11,11,11,11,11,11,11,10,10,10,10,10,10,10,10,10,10,10,10,10,10,10,10,10,10,10,10,10,10,10,9,9,9,9,9,9,9,9,9,9,9,9,8,8,8,8,8,8,8,7,6,5,4,3,2,1,0,17,18,19,20,21,22,23,24,24,24,24,24,24,24,25,25,25,25,25,25,25,25,25,25,25,25,26,26,26,26,26,26,26,26,26,26,26,26,26,26,26,26,26,26,26,26,26,26,26,27,27,27,27,27,27,27,27,27,27,27,27,27,27,27},
 {13,13,13,13,13,13,13,13,13,13,13,13,13,13,13,13,13,13,13,13,13,13,13,12,12,12,12,12,12,12,12,12,12,12,12,12,12,12,12,12,12,12,11,11,11,11,11,11,11,11,11,11,10,10,10,10,10,10,9,9,9,8,8,4,0,20,24,24,25,25,25,26,26,26,26,26,26,27,27,27,27,27,27,27,27,27,27,28,28,28,28,28,28,28,28,28,28,28,28,28,28,28,28,28,28,28,29,29,29,29,29,29,29,29,29,29,29,29,29,29,29,29,29,29,29,29,29,29,29},
 {15,15,15,15,15,15,15,15,15,15,15,15,15,15,15,15,15,15,15,15,15,15,15,15,15,15,15,15,15,15,14,14,14,14,14,14,14,14,14,14,14,14,14,14,14,13,13,13,13,13,13,13,13,13,12,12,12,12,12,11,11,10,10,9,0,25,26,26,27,27,28,28,28,28,28,29,29,29,29,29,29,29,29,29,30,30,30,30,30,30,30,30,30,30,30,30,30,30,30,31,31,31,31,31,31,31,31,31,31,31,31,31,31,31,31,31,31,31,31,31,31,31,31,31,31,31,31,31,31}};
__device__ __forceinline__ s16x4 vtr(const LAS unsigned char* p) { return __builtin_bit_cast(s16x4, __builtin_amdgcn_ds_read_tr16_b64_v4i16((LAS s16x4*)p)); }

template <int PASS>
__device__ __forceinline__ void unit_pass(LAS unsigned char* lds, const bf16* Qbh, const bf16* Kbh, const bf16* Vbh, int T0, int wave, int lane_in) {
    constexpr int d = PASS == 0 ? 1 : (PASS == 1 ? 4 : 16), dsh = PASS == 0 ? 0 : (PASS == 1 ? 2 : 4), NBLK = PASS == 2 ? 10 : 5;
    int lane = lane_in; asm volatile("" : "+v"(lane));
    const int r32 = lane & 31, hh = lane >> 5;
    auto qloc = [&](int i) -> int { return PASS == 0 ? 32 * wave + i : (PASS == 1 ? (wave & 3) + 4 * (32 * (wave >> 2) + i) : 2 * wave + (i >> 4) + 16 * (i & 15)); };
    const int tq = T0 + qloc(r32);
    bf16x8 qf[4];
#pragma unroll
    for (int ks = 0; ks < 4; ++ks) qf[ks] = *(const bf16x8*)(Qbh + (size_t)tq * 512 + 16 * ks + 8 * hh);
    const LAS float* bias = (const LAS float*)(lds + A_BIAS) + PASS * 132;
    LAS unsigned char* vst = lds + A_V + wave * 8192;
    const LAS unsigned char* vrd = vst + ((lane >> 4) & 1) * 32 + (lane & 3) * 8 + (4 * hh + ((lane & 15) >> 2)) * 64;
    f32x16 o[2] = {}; float lp = 0.f;
#pragma unroll 1
    for (int blk = 0; blk < NBLK; ++blk) {
        int kbase;
        if (PASS == 0) kbase = T0 + 32 * wave + 32 * (blk - 2);
        else if (PASS == 1) kbase = T0 + (wave & 3) + 4 * (32 * (wave >> 2) + 32 * (blk - 2));
        else kbase = T0 + 2 * wave + (blk >= 5 ? 1 : 0) + 16 * 32 * ((blk >= 5 ? blk - 5 : blk) - 2);
        asm volatile("s_waitcnt lgkmcnt(0)" ::: "memory");
#pragma unroll
        for (int pc = 0; pc < 4; ++pc) { const int d0 = pc >> 1, kg = pc & 1; int kt = kbase + d * (16 * kg + (lane >> 2)); kt = kt < 0 ? 0 : (kt > SEQ - 1 ? SEQ - 1 : kt);
            __builtin_amdgcn_global_load_lds((const unsigned*)(Vbh + (size_t)kt * 512 + 32 * d0 + (lane & 3) * 8), (LAS unsigned*)(vst + pc * 1024), 16, 0, 0); }
        int ktr = kbase + d * r32; ktr = ktr < 0 ? 0 : (ktr > SEQ - 1 ? SEQ - 1 : ktr);
        f32x16 acc = {};
#pragma unroll
        for (int ks = 0; ks < 4; ++ks) acc = mfma32(*(const bf16x8*)(Kbh + (size_t)ktr * 512 + 16 * ks + 8 * hh), qf[ks], acc);
        f32x16 p;
#pragma unroll
        for (int r = 0; r < 16; ++r) {
            const int kt = kbase + d * crow(r, hh), rel = kt - tq;
            const bool ok = (kt >= 0) && (kt < SEQ) && ((rel & (d - 1)) == 0) && (rel >= -64 * d) && (rel <= 64 * d);
            const float bv = bias[ok ? (rel >> dsh) + 64 : 64];
            p[r] = ok ? __expf(acc[r] + bv) : 0.f;
            lp += p[r];
        }
        asm volatile("s_waitcnt vmcnt(0)" ::: "memory");
        __builtin_amdgcn_sched_barrier(0);
#pragma unroll
        for (int s = 0; s < 2; ++s) {
            const bf16x8 pa = pack8(p, 8 * s);
#pragma unroll
            for (int d0 = 0; d0 < 2; ++d0) {
                const s16x4 lo = vtr(vrd + d0 * 2048 + s * 1024), hi = vtr(vrd + d0 * 2048 + s * 1024 + 512);
                const bf16x8 vf = (bf16x8){lo[0], lo[1], lo[2], lo[3], hi[0], hi[1], hi[2], hi[3]};
                o[d0] = mfma32(pa, vf, o[d0]);
            }
        }
    }
    lp += __shfl_xor(lp, 32);
    LAS float* Oacc = (LAS float*)(lds + A_OACC); LAS float* Lacc = (LAS float*)(lds + A_L);
    if (hh == 0) { const int ql = qloc(r32); if (PASS == 0) Lacc[ql] = lp; else Lacc[ql] += lp; }
#pragma unroll
    for (int r = 0; r < 16; ++r) { const int ql = qloc(crow(r, hh));
#pragma unroll
        for (int d0 = 0; d0 < 2; ++d0) { LAS float* dst = Oacc + ql * 64 + 32 * d0 + r32; if (PASS == 0) *dst = o[d0][r]; else *dst += o[d0][r]; } }
    asm volatile("s_waitcnt vmcnt(0) lgkmcnt(0)" ::: "memory"); __syncthreads();
}

__device__ __forceinline__ void unit(LAS unsigned char* lds, const bf16* QB, const bf16* KB, const bf16* VB, const float* rel_bias, bf16* AO, int u, int wave, int lane) {
    const int bh = u >> 5, b = bh >> 3, h = bh & 7, T0 = (u & 31) * 256;
    for (int i = threadIdx.x; i < 387; i += NWAVES * 64) { const int p = i / 129, jj = i - 129 * p; ((LAS float*)(lds + A_BIAS))[p * 132 + jj] = rel_bias[(int)BUCKET[p][jj] * AH + h]; }
    asm volatile("s_waitcnt vmcnt(0) lgkmcnt(0)" ::: "memory"); __syncthreads();
    const size_t hb = (size_t)b * SEQ * 512 + h * 64;
    unit_pass<0>(lds, QB + hb, KB + hb, VB + hb, T0, wave, lane);
    unit_pass<1>(lds, QB + hb, KB + hb, VB + hb, T0, wave, lane);
    unit_pass<2>(lds, QB + hb, KB + hb, VB + hb, T0, wave, lane);
    {
        const int tl = threadIdx.x >> 1, half = threadIdx.x & 1;
        const LAS f32x4* src = (const LAS f32x4*)(lds + A_OACC + (tl * 64 + 32 * half) * 4);
        const float rl = 1.0f / ((const LAS float*)(lds + A_L))[tl];
        bf16* dst = AO + ((size_t)b * SEQ + T0 + tl) * 512 + h * 64 + 32 * half;
#pragma unroll
        for (int q4 = 0; q4 < 4; ++q4) { const f32x4 x0 = src[2 * q4] * rl, x1 = src[2 * q4 + 1] * rl;
            *(u32x4*)(dst + 8 * q4) = (u32x4){gdn::pkbf(x0[0], x0[1]), gdn::pkbf(x0[2], x0[3]), gdn::pkbf(x1[0], x1[1]), gdn::pkbf(x1[2], x1[3])}; }
    }
    asm volatile("s_waitcnt lgkmcnt(0)" ::: "memory"); __syncthreads();
}
}
constexpr int N_PHASES = 11;
__global__ void __launch_bounds__(NWAVES * 64, 2) mk_fwd(Args args) {
    extern __shared__ __attribute__((aligned(16))) unsigned char lds[];
    Frame F;
    F.lds = (LAS unsigned char*)lds; F.MISC = (volatile LAS unsigned*)(F.lds + MISC_OFF);
    F.wave = __builtin_amdgcn_readfirstlane((int)threadIdx.x >> 6);
    F.G = gridDim.x; { const int bx = blockIdx.x; F.vcu = (F.G % 8 == 0) ? (bx % 8) * (F.G / 8) + bx / 8 : bx; }
    unsigned char* ws = args.ws;
    F.ctl = (gu32*)(ws + WS_CTL);
    for (int u = (int)threadIdx.x; u < (LDS_BYTES - LDSCTL_OFF) / 4; u += NWAVES * 64) ((LAS unsigned*)(F.lds + LDSCTL_OFF))[u] = 0u;
    __syncthreads();
    XcdBarrier bar = xcd_barrier_post((unsigned*)(F.ctl + CW_BAR) + args.li * XCD_BAR_WORDS, F.MISC + 8);
    const int lo = args.ph_lo, hi = args.ph_hi;
#define IN(k) (lo <= (k) && (k) < hi)
#define SEAM(k) do { if (IN(k) && IN((k) + 1)) xcd_barrier(bar); } while (0)
    bf16* XB = (bf16*)(ws + WS_XB); bf16* XB2 = (bf16*)(ws + WS_XB2); bf16* ACT = (bf16*)(ws + WS_ACT);
    float* SS1 = (float*)(ws + WS_SS1); float* SS2 = (float*)(ws + WS_SS2); float* SS3 = (float*)(ws + WS_SS3); float* SS4 = (float*)(ws + WS_SS4);
    const int gw = F.vcu * NWAVES + F.wave, NGW = F.G * NWAVES;

    if (IN(0)) {
        LAS float* scr = (LAS float*)(F.lds + RING_OFF + F.wave * 16384);
        constexpr int NITEMS = I_GU + I_D + I_IN + I_OUT;
        for (int it = gw; it < NITEMS; it += NGW) p0_weight_item(args, 0, it, scr, (int)(threadIdx.x & 63));
        if (blockIdx.x == 0 && (int)threadIdx.x < 192) { float* nwt = (float*)(ws + WS_NWT); nwt[(int)threadIdx.x] = (int)threadIdx.x < 64 ? args.in[IN_QNORM][(int)threadIdx.x] * 0.125f : ((int)threadIdx.x < 128 ? args.in[IN_KNORM][(int)threadIdx.x - 64] : 1.0f); }
        for (int m = gw; m < M; m += NGW) x_row_to_bf16(args.in[IN_X] + (size_t)m * D, XB + (size_t)m * D, SS1 + m, (int)(threadIdx.x & 63));
    }
    SEAM(0);
    if (IN(1)) {
        pg8::Gemm g{XB, (const bf16*)(ws + WS_WGU1), M, NGU, D}; pg8::StaticOrder S; S.init(M, NGU, F.G, (int)blockIdx.x);
        pg8::EpiSwiGLU E{ACT, FF, SS1};
        pg8::gemm_phase<pg8::EpiSwiGLU, pg8::StaticOrder, true, true>(F.lds + RING_OFF, g, S, E);
    }
    SEAM(1);
    if (IN(2)) {
        pg8::Gemm g{ACT, (const bf16*)(ws + WS_WD1), M, D, FF}; pg8::StaticOrder S; S.init(M, D, F.G, (int)blockIdx.x);
        pg8::EpiResid E{args.in[IN_X], args.out, XB, SS2, 0.5f};
        pg8::gemm_phase<pg8::EpiResid, pg8::StaticOrder, true, true>(F.lds + RING_OFF, g, S, E);
    }
    SEAM(2);
    if (IN(3)) {
        pg8::Gemm g{XB, (const bf16*)(ws + WS_WIN), M, NIN_PAD, D}; pg8::StaticOrder S; S.init(M, NIN_PAD, F.G, (int)blockIdx.x);
        pg8::EpiProj E{(bf16*)(ws + WS_QKVA), (bf16*)(ws + WS_QB), (float*)(ws + WS_AB), SS2, (const float*)(ws + WS_NWT)};
        pg8::gemm_phase<pg8::EpiProj, pg8::StaticOrder, true, true>(F.lds + RING_OFF, g, S, E);
    }
    SEAM(3);
    const gdn::Bufs GB{(const bf16*)(ws + WS_QKVA), (const float*)(ws + WS_AB), (bf16*)(ws + WS_QF), (bf16*)(ws + WS_KT), (bf16*)(ws + WS_WF), (bf16*)(ws + WS_IF), (bf16*)(ws + WS_UC), (float*)(ws + WS_SCAL), (unsigned*)(ws + 208 * 1024)};
    if (IN(4)) {
        for (int it = blockIdx.x; it < 8 * 128; it += F.G) gdn::prep_item(F.lds + RING_OFF, GB, args.in[IN_CONVW], args.in[IN_ALOG], args.in[IN_DTBIAS], it >> 7, it & 127, F.wave, (int)(threadIdx.x & 63));
    }
    SEAM(4);
    if (IN(5)) {
        if (blockIdx.x < 16) { if (F.wave < 4) gdn::scan_wave(GB, (int)blockIdx.x, F.wave, (int)(threadIdx.x & 63)); }
        else for (int u = (int)blockIdx.x - 16; u < 512; u += F.G - 16)
            attn::unit(F.lds + RING_OFF, (const bf16*)(ws + WS_QB), (const bf16*)(ws + WS_KB), (const bf16*)(ws + WS_VB), args.in[IN_RELBIAS], (bf16*)(ws + WS_AO), u, F.wave, (int)(threadIdx.x & 63));
    }
    SEAM(5);
    if (IN(6)) {
        for (int it = gw; it < 8 * 128 * 2; it += NGW) gdn::finalize_item(GB, (const bf16*)(ws + WS_Z), args.in[IN_GDN_NORM], XB, it, (int)(threadIdx.x & 63));
        for (int m = gw; m < M; m += NGW) *(GAS v4u*)(XB + (size_t)m * D + 512 + (threadIdx.x & 63) * 8) = *(const GAS v4u*)((const bf16*)(ws + WS_AO) + (size_t)m * 512 + (threadIdx.x & 63) * 8);
        LAS float* scr = (LAS float*)(F.lds + RING_OFF + F.wave * 16384);
        for (int it = gw; it < I_GU + I_D; it += NGW) p0_weight_item(args, 1, it, scr, (int)(threadIdx.x & 63));
    }
    SEAM(6);
    if (IN(7)) {
        pg8::Gemm g{XB, (const bf16*)(ws + WS_WOUT), M, D, D}; pg8::StaticOrder S; S.init(M, D, F.G, (int)blockIdx.x);
        pg8::EpiResid E{args.out, args.out, XB2, SS3, 1.0f};
        pg8::gemm_phase<pg8::EpiResid, pg8::StaticOrder, true, true>(F.lds + RING_OFF, g, S, E);
    }
    SEAM(7);
    if (IN(8)) {
        pg8::Gemm g{XB2, (const bf16*)(ws + WS_WGU2), M, NGU, D}; pg8::StaticOrder S; S.init(M, NGU, F.G, (int)blockIdx.x);
        pg8::EpiSwiGLU E{ACT, FF, SS3};
        pg8::gemm_phase<pg8::EpiSwiGLU, pg8::StaticOrder, true, true>(F.lds + RING_OFF, g, S, E);
    }
    SEAM(8);
    if (IN(9)) {
        pg8::Gemm g{ACT, (const bf16*)(ws + WS_WD2), M, D, FF}; pg8::StaticOrder S; S.init(M, D, F.G, (int)blockIdx.x);
        pg8::EpiResid E{args.out, args.out, nullptr, SS4, 0.5f};
        pg8::gemm_phase<pg8::EpiResid, pg8::StaticOrder, true, true>(F.lds + RING_OFF, g, S, E);
    }
    SEAM(9);
    if (IN(10)) {
        for (int m = gw; m < M; m += NGW) final_norm_row(args.out + (size_t)m * D, args.in[IN_FINAL_NORM], SS4[m], (int)(threadIdx.x & 63));
    }
#undef IN
#undef SEAM
}

namespace ref {
constexpr int CONVW = 5;
__device__ const unsigned char BUCKET[3][129] = {
 {11,11,11,11,11,11,11,11,11,11,11,11,11,11,11,10,10,10,10,10,10,10,10,10,10,10,10,10,10,10,10,10,10,10,10,10,10,10,9,9,9,9,9,9,9,9,9,9,9,9,8,8,8,8,8,8,8,7,6,5,4,3,2,1,0,17,18,19,20,21,22,23,24,24,24,24,24,24,24,25,25,25,25,25,25,25,25,25,25,25,25,26,26,26,26,26,26,26,26,26,26,26,26,26,26,26,26,26,26,26,26,26,26,26,27,27,27,27,27,27,27,27,27,27,27,27,27,27,27},
 {13,13,13,13,13,13,13,13,13,13,13,13,13,13,13,13,13,13,13,13,13,13,13,12,12,12,12,12,12,12,12,12,12,12,12,12,12,12,12,12,12,12,11,11,11,11,11,11,11,11,11,11,10,10,10,10,10,10,9,9,9,8,8,4,0,20,24,24,25,25,25,26,26,26,26,26,26,27,27,27,27,27,27,27,27,27,27,28,28,28,28,28,28,28,28,28,28,28,28,28,28,28,28,28,28,28,29,29,29,29,29,29,29,29,29,29,29,29,29,29,29,29,29,29,29,29,29,29,29},
 {15,15,15,15,15,15,15,15,15,15,15,15,15,15,15,15,15,15,15,15,15,15,15,15,15,15,15,15,15,15,14,14,14,14,14,14,14,14,14,14,14,14,14,14,14,13,13,13,13,13,13,13,13,13,12,12,12,12,12,11,11,10,10,9,0,25,26,26,27,27,28,28,28,28,28,29,29,29,29,29,29,29,29,29,30,30,30,30,30,30,30,30,30,30,30,30,30,30,30,31,31,31,31,31,31,31,31,31,31,31,31,31,31,31,31,31,31,31,31,31,31,31,31,31,31,31,31,31,31}};
__device__ __forceinline__ float wave_max(float v) {
#pragma unroll
    for (int o = 1; o < 64; o <<= 1) v = fmaxf(v, __shfl_xor(v, o));
    return v;
}
__device__ __forceinline__ float silu(float x) { return x / (1.f + __expf(-x)); }
__global__ void __launch_bounds__(256) gdn_pre_k(const bf16* __restrict__ qkva, const float* __restrict__ ab, const float* __restrict__ conv_w, const float* __restrict__ a_log, const float* __restrict__ dt_bias,
                                                 bf16* __restrict__ qkvc, float* __restrict__ gbuf, float* __restrict__ bbuf) {
    __shared__ float sums[12];
    const int t = blockIdx.x, tid = threadIdx.x;
    if (tid < 12) sums[tid] = 0.f;
    __syncthreads();
    float val[6];
#pragma unroll
    for (int i = 0; i < 6; ++i) {
        const int c = tid + 256 * i;
        float s = 0.f;
#pragma unroll
        for (int j = 0; j < CONVW; ++j) { const int tt = t + j - 2; if (tt >= 0 && tt < SEQ) s += bf2f(qkva[(size_t)tt * 1536 + c]) * conv_w[c * CONVW + j]; }
        val[i] = silu(s);
        if (c < 1024) atomicAdd(&sums[c >> 7], val[i] * val[i]);
    }
    __syncthreads();
#pragma unroll
    for (int i = 0; i < 6; ++i) {
        const int c = tid + 256 * i;
        float v = val[i];
        if (c < 1024) v *= rsqrtf(sums[c >> 7] + EPS);
        qkvc[(size_t)t * 1536 + c] = (bf16)f2bf(v);
    }
    if (tid < 8) {
        const float a = ab[(size_t)t * 16 + tid] + dt_bias[tid];
        const float sp = (a > 20.f) ? a : log1pf(expf(a));
        gbuf[(size_t)tid * SEQ + t] = -expf(a_log[tid]) * sp;
        const float b = ab[(size_t)t * 16 + 8 + tid];
        bbuf[(size_t)tid * SEQ + t] = 1.f / (1.f + expf(-b));
    }
}
__global__ void __launch_bounds__(1024) gdn_rec_k(const bf16* __restrict__ qkvc, const float* __restrict__ gbuf, const float* __restrict__ bbuf, float* __restrict__ o2) {
    const int dir = blockIdx.x >> 2, h = blockIdx.x & 3, tid = threadIdx.x, dv = tid >> 3, seg = tid & 7;
    float R[16];
#pragma unroll
    for (int i = 0; i < 16; ++i) R[i] = 0.f;
    const float* gp = gbuf + (size_t)(dir * 4 + h) * SEQ; const float* bp = bbuf + (size_t)(dir * 4 + h) * SEQ;
    float* op = o2 + (size_t)dir * SEQ * GW;
    const float qs = 0.08838834764831845f;
    for (int s = 0; s < SEQ; ++s) {
        const int t = dir ? (SEQ - 1 - s) : s;
        const bf16* row = qkvc + (size_t)t * 1536;
        float k[16], q[16];
#pragma unroll
        for (int i = 0; i < 16; ++i) { k[i] = bf2f(row[512 + h * 128 + seg * 16 + i]); q[i] = bf2f(row[h * 128 + seg * 16 + i]); }
        const float v = bf2f(row[1024 + h * 128 + dv]);
        const float eg = expf(gp[t]), beta = bp[t];
        float p = 0.f;
#pragma unroll
        for (int i = 0; i < 16; ++i) p += R[i] * k[i];
        p += __shfl_xor(p, 1); p += __shfl_xor(p, 2); p += __shfl_xor(p, 4);
        const float delta = beta * (v - eg * p);
        float o = 0.f;
#pragma unroll
        for (int i = 0; i < 16; ++i) { R[i] = eg * R[i] + delta * k[i]; o += R[i] * q[i]; }
        o += __shfl_xor(o, 1); o += __shfl_xor(o, 2); o += __shfl_xor(o, 4);
        if (seg == 0) op[(size_t)t * GW + h * 128 + dv] = o * qs;
    }
}
__global__ void __launch_bounds__(512) gdn_post_k(const float* __restrict__ o2, const bf16* __restrict__ z, const float* __restrict__ nw, bf16* __restrict__ mix, int ldm) {
    __shared__ float sums[4];
    const int t = blockIdx.x, c = threadIdx.x;
    if (c < 4) sums[c] = 0.f;
    __syncthreads();
    const float o = o2[(size_t)t * GW + c] + o2[(size_t)SEQ * GW + (size_t)t * GW + c];
    atomicAdd(&sums[c >> 7], o * o);
    __syncthreads();
    mix[(size_t)t * ldm + c] = (bf16)f2bf(o * rsqrtf(sums[c >> 7] * (1.f / 128.f) + EPS) * nw[c & 127] * silu(bf2f(z[(size_t)t * 512 + c])));
}
__global__ void __launch_bounds__(256) attn_k(const bf16* __restrict__ qb, const bf16* __restrict__ kb, const bf16* __restrict__ vb, const float* __restrict__ rel_bias, bf16* __restrict__ mix) {
    const int gw = blockIdx.x * 4 + (threadIdx.x >> 6), lane = threadIdx.x & 63;
    const int t = gw >> 3, h = gw & 7;
    const float qv = bf2f(qb[(size_t)t * 512 + h * 64 + lane]);
    float qa[64];
#pragma unroll
    for (int dd = 0; dd < 64; ++dd) qa[dd] = __shfl(qv, dd);
    float sc[7]; int pos[7];
    float mx = -1e30f;
#pragma unroll
    for (int r = 0; r < 7; ++r) {
        const int e = lane + 64 * r;
        float s = -1e30f; int kp = -1;
        if (e < 387) {
            const int p = e / 129, j = e % 129 - 64, d = (p == 0) ? 1 : (p == 1 ? 4 : 16);
            kp = t + d * j;
            if (kp >= 0 && kp < SEQ) {
                const bf16* kr = kb + (size_t)kp * 512 + h * 64;
                float a = 0.f;
#pragma unroll
                for (int dd = 0; dd < 64; ++dd) a += qa[dd] * bf2f(kr[dd]);
                s = a + rel_bias[(int)BUCKET[p][j + 64] * AH + h];
            } else kp = -1;
        }
        sc[r] = s; pos[r] = kp; mx = fmaxf(mx, s);
    }
    mx = wave_max(mx);
    float l = 0.f;
#pragma unroll
    for (int r = 0; r < 7; ++r) { sc[r] = (pos[r] >= 0) ? __expf(sc[r] - mx) : 0.f; l += sc[r]; }
    l = wave_sum(l);
    float o = 0.f;
#pragma unroll
    for (int r = 0; r < 7; ++r) {
        for (int src = 0; src < 64; ++src) {
            const float pe = __shfl(sc[r], src); const int kp = __shfl(pos[r], src);
            if (kp >= 0) o += pe * bf2f(vb[(size_t)kp * 512 + h * 64 + lane]);
        }
    }
    mix[(size_t)t * D + 512 + h * 64 + lane] = (bf16)f2bf(o / l);
}
__global__ void __launch_bounds__(512) diff_k(bf16* mine, const bf16* refv, unsigned* maxbits) {
    const int t = blockIdx.x, c = threadIdx.x;
    const float a = bf2f(mine[(size_t)t * D + c]), r = bf2f(refv[(size_t)t * 512 + c]);
    float d = fabsf(a - r); if (!(d == d)) d = 7777.f;
    d = wave_max(d);
    if ((c & 63) == 0) atomicMax(maxbits, __float_as_uint(d));
    mine[(size_t)t * D + c] = refv[(size_t)t * 512 + c];
}
__global__ void poke_k(float* out, const unsigned* maxbits) { out[0] = 1000.f * __uint_as_float(*maxbits); }
__global__ void poke_code_k(float* out, const unsigned* code) { out[0] = 1000.f * (float)(*code); }
__global__ void __launch_bounds__(256) nanpos_bf16_k(const bf16* p, size_t n, unsigned* w) {
    unsigned cnt = 0, best = 0;
    for (size_t i = (size_t)blockIdx.x * 256 + threadIdx.x; i < n; i += (size_t)gridDim.x * 256) { if ((p[i] & 0x7f80u) == 0x7f80u) { ++cnt; const unsigned inv = 0xffffffffu - (unsigned)i; best = inv > best ? inv : best; } }
    if (cnt) { atomicAdd(w, cnt); atomicMax(w + 1, best); }
}
__global__ void poke_nanpos_k(float* out, const unsigned* w) {
    const unsigned cnt = w[0]; const unsigned idx = w[1] ? 0xffffffffu - w[1] : 0u;
    int lc = 0; for (unsigned c = cnt; c >= 10; c /= 10) ++lc;
#if NANPOS_MODE == 0
    const unsigned code = (lc > 9 ? 9 : lc) * 10 + ((idx >> 13) & 127) / 16;
#elif NANPOS_MODE == 1
    const unsigned code = ((idx >> 10) & 7) * 10 + ((idx & 15) >> 1);
#else
    const unsigned code = ((idx >> 4) & 63);
#endif
    out[0] = 1000.f * (float)code;
}
__global__ void poke_cat3_k(float* out, const unsigned* mx) {
    unsigned code = 0;
    for (int k = 2; k >= 0; --k) { const float v = __uint_as_float(mx[k]); int cat = (v != v) ? 3 : (v < 2.f ? 0 : (v < 1e4f ? 1 : 2)); code = code * 4 + cat; }
    out[0] = 1000.f * (float)code;
}
__global__ void poke_cat_k(float* out, const unsigned* mx) {
    unsigned code = 0;
    for (int k = 1; k >= 0; --k) { const float v = __uint_as_float(mx[k]); int cat = (v != v) ? 5 : (v < 10.f ? 0 : (v < 100.f ? 1 : (v < 1e4f ? 2 : (v < 1e10f ? 3 : 4)))); code = code * 6 + cat; }
    out[0] = 1000.f * (float)code;
}
__global__ void __launch_bounds__(256) maxabs_bf16_k(const bf16* p, size_t n, unsigned* mx) {
    unsigned best = 0;
    for (size_t i = (size_t)blockIdx.x * 256 + threadIdx.x; i < n; i += (size_t)gridDim.x * 256) { const unsigned b = ((unsigned)p[i] << 16) & 0x7fffffffu; best = b > best ? b : best; }
    atomicMax(mx, best);
}
__global__ void __launch_bounds__(256) chk_bf16_k(const bf16* p, size_t n, unsigned* code, unsigned bit) {
    bool bad = false;
    for (size_t i = (size_t)blockIdx.x * 256 + threadIdx.x; i < n; i += (size_t)gridDim.x * 256) { const float v = bf2f(p[i]); if (!(fabsf(v) < 1e4f)) bad = true; }
    if (__any(bad) && (threadIdx.x & 63) == 0) atomicOr(code, bit);
}
__global__ void __launch_bounds__(256) chk_f32_k(const float* p, size_t n, unsigned* code, unsigned bit) {
    bool bad = false;
    for (size_t i = (size_t)blockIdx.x * 256 + threadIdx.x; i < n; i += (size_t)gridDim.x * 256) { const float v = p[i]; if (!(fabsf(v) < 1e4f)) bad = true; }
    if (__any(bad) && (threadIdx.x & 63) == 0) atomicOr(code, bit);
}
}

extern "C" void kernel_launch(void* const* d_in, const int* in_sizes, int n_in, void* d_out, int out_size, void* d_ws, size_t ws_size, hipStream_t stream) {
    static int grid = 0;
    if (grid == 0) {
        if (n_in != 20 || in_sizes[0] != M * D || out_size != M * D || ws_size < WS_END) { fprintf(stderr, "kernel_launch: unexpected shapes (n_in %d, in0 %d, out %d, ws %zu)\n", n_in, n_in > 0 ? in_sizes[0] : -1, out_size, ws_size); grid = -1; return; }
        int dev = 0, cus = 0, per_cu = 0;
        if (hipGetDevice(&dev) != hipSuccess || hipDeviceGetAttribute(&cus, hipDeviceAttributeMultiprocessorCount, dev) != hipSuccess) { grid = -1; return; }
        if (hipFuncSetAttribute((const void*)mk_fwd, hipFuncAttributeMaxDynamicSharedMemorySize, LDS_BYTES) != hipSuccess) { fprintf(stderr, "kernel_launch: hipFuncSetAttribute failed\n"); grid = -1; return; }
        if (hipOccupancyMaxActiveBlocksPerMultiprocessor(&per_cu, (const void*)mk_fwd, NWAVES * 64, LDS_BYTES) != hipSuccess || per_cu < 1) { fprintf(stderr, "kernel_launch: occupancy query reports %d\n", per_cu); per_cu = 1; }
        (void)hipGetLastError();
        grid = cus;
    }
    if (grid < 0) return;
    unsigned char* ws = (unsigned char*)d_ws;
    (void)hipMemsetAsync(ws + WS_CTL, 0, CTL_ZERO_BYTES, stream);
    Args a{};
    for (int i = 0; i < 20; ++i) a.in[i] = (const float*)d_in[i];
    a.out = (float*)d_out; a.ws = ws;
    a.ph_lo = 0; a.ph_hi = N_PHASES; a.li = 0;
    hipLaunchKernelGGL(mk_fwd, dim3(grid), dim3(NWAVES * 64), LDS_BYTES, stream, a);
}
```

```cpp
#include <hip/hip_runtime.h>
#include <cstdio>
#include <cstdint>
namespace pg8 {
#define PG8_LAS __attribute__((address_space(3)))
typedef unsigned short bf16_t;
typedef short bf16x8 __attribute__((ext_vector_type(8)));
typedef float f32x4 __attribute__((ext_vector_type(4)));
typedef unsigned u32x4 __attribute__((ext_vector_type(4)));
constexpr int BM = 256, BK = 64, HALF = 128, HTB = HALF * BK * 2  , STAGE_BYTES = 8 * HTB, NXCD = 8, WGM = 8;

__host__ __device__ __forceinline__ int lds_byte(int r, int c) { const int st = (r >> 4) * 2 + (c >> 5), rr = r & 15, cc = c & 31, ob = rr * 64 + cc * 2; return st * 1024 + (ob ^ (((ob >> 9) & 1) << 5)); }
__host__ __device__ __forceinline__ void stage_rc(int b, int& R, int& C) { const int st = b / 1024, sb = b % 1024, swz = sb ^ (((sb >> 9) & 1) << 5); R = (st >> 1) * 16 + swz / 64; C = (st & 1) * 32 + (swz % 64) / 2; }
__host__ __device__ __forceinline__ int perm32(int rho) { const int n = rho >> 4, i = rho & 15; return 8 * (i >> 2) + 4 * n + (i & 3); }

struct Unit { int pm, pn; };
struct Gemm { const bf16_t* A; const bf16_t* Bt; int M, N, K; };

struct StaticOrder {
    int nM, nN, nwg, G, c;
    __host__ __device__ void init(int M, int N, int G_, int c_) { nM = M / BM; nN = N / BM; nwg = nM * nN; G = G_; c = c_; }
    __host__ __device__ bool next(int i, Unit& u) const {
        const long L = (long)i * G + c; if (L >= nwg) return false;
        int wgid = (int)L; { const int q = nwg / NXCD, r = nwg % NXCD, xcd = wgid % NXCD, off = wgid / NXCD; wgid = (xcd < r ? xcd * (q + 1) : r * (q + 1) + (xcd - r) * q) + off; }
        const int nig = WGM * nN, gid = wgid / nig, fm = gid * WGM, gsz = (nM - fm) < WGM ? (nM - fm) : WGM;
        u.pm = fm + ((wgid % nig) % gsz); u.pn = (wgid % nig) / gsz; return true;
    }
    __device__ __forceinline__ void a_ready(const Unit&) const {}
    __device__ __forceinline__ void done(const Unit&) const {}
};

__device__ __forceinline__ unsigned cvt_pk_bf16(float lo, float hi) { unsigned r; asm volatile("v_cvt_pk_bf16_f32 %0, %1, %2" : "=v"(r) : "v"(lo), "v"(hi)); return r; }
__device__ __forceinline__ float fast_silu(float x) { return x * __builtin_amdgcn_rcpf(1.0f + __builtin_amdgcn_exp2f(-1.4426950408889634f * x)); }
constexpr float RMS_EPS = 1e-6f;

struct EpiSwiGLU {
    static constexpr bool PERM = true, AFTER_DRAIN = false;
    bf16_t* O; int ldc; const float* ss;
    __device__ __forceinline__ void operator()(const f32x4 (&acc)[2][2][4][2], const Unit& u, int wr, int wc, int fr, int fq) const {
        const int row0 = u.pm * BM + wr * 64 + fr, col0 = u.pn * HALF + wc * 32 + 8 * fq;
#pragma unroll
        for (int ai = 0; ai < 2; ++ai)
#pragma unroll
            for (int m = 0; m < 4; ++m) {
                const int row = row0 + ai * HALF + m * 16;
                const float r = rsqrtf(ss[row] * (1.0f / 1024.0f) + RMS_EPS);
                const f32x4 g0 = acc[ai][0][m][0] * r, g1 = acc[ai][0][m][1] * r, u0 = acc[ai][1][m][0] * r, u1 = acc[ai][1][m][1] * r;
                u32x4 w;
                w.x = cvt_pk_bf16(fast_silu(g0[0]) * u0[0], fast_silu(g0[1]) * u0[1]); w.y = cvt_pk_bf16(fast_silu(g0[2]) * u0[2], fast_silu(g0[3]) * u0[3]);
                w.z = cvt_pk_bf16(fast_silu(g1[0]) * u1[0], fast_silu(g1[1]) * u1[1]); w.w = cvt_pk_bf16(fast_silu(g1[2]) * u1[2], fast_silu(g1[3]) * u1[3]);
                *(u32x4*)(O + (size_t)row * ldc + col0) = w;
            }
    }
};
struct EpiResid {
    static constexpr bool PERM = true, AFTER_DRAIN = false;
    const float* base; float* out; bf16_t* xb; float* ss_out; float alpha;
    __device__ __forceinline__ void operator()(const f32x4 (&acc)[2][2][4][2], const Unit& u, int wr, int wc, int fr, int fq) const {
        const int row0 = u.pm * BM + wr * 64 + fr, col0 = u.pn * BM + wc * 32 + 8 * fq;
#pragma unroll
        for (int ai = 0; ai < 2; ++ai)
#pragma unroll
            for (int m = 0; m < 4; ++m) {
                const int row = row0 + ai * HALF + m * 16; float s = 0.f;
#pragma unroll
                for (int bj = 0; bj < 2; ++bj) {
                    const size_t off = (size_t)row * 1024 + col0 + bj * HALF;
                    const f32x4 b0 = *(const f32x4*)(base + off), b1 = *(const f32x4*)(base + off + 4);
                    const f32x4 v0 = b0 + acc[ai][bj][m][0] * alpha, v1 = b1 + acc[ai][bj][m][1] * alpha;
                    *(f32x4*)(out + off) = v0; *(f32x4*)(out + off + 4) = v1;
                    if (xb) { u32x4 w; w.x = cvt_pk_bf16(v0[0], v0[1]); w.y = cvt_pk_bf16(v0[2], v0[3]); w.z = cvt_pk_bf16(v1[0], v1[1]); w.w = cvt_pk_bf16(v1[2], v1[3]); *(u32x4*)(xb + off) = w; }
                    s += (v0[0] * v0[0] + v0[1] * v0[1]) + (v0[2] * v0[2] + v0[3] * v0[3]) + (v1[0] * v1[0] + v1[1] * v1[1]) + (v1[2] * v1[2] + v1[3] * v1[3]);
                }
                if (ss_out) { s += __shfl_xor(s, 16); s += __shfl_xor(s, 32); if (fq == 0) atomicAdd(ss_out + row, s); }
            }
    }
};
struct EpiProj {
    static constexpr bool PERM = true, AFTER_DRAIN = false;
    bf16_t* qkva; bf16_t* qkvb; float* ab; const float* ss; const float* nwt;
    static constexpr size_t Z_OFF = (size_t)16384 * 1536, QKVB_STRIDE = (size_t)16384 * 512;
    __device__ __forceinline__ void operator()(const f32x4 (&acc)[2][2][4][2], const Unit& u, int wr, int wc, int fr, int fq) const {
        const int row0 = u.pm * BM + wr * 64 + fr, pn = u.pn;
        if (pn < 8) {
            bf16_t* dst = qkva + (pn < 6 ? (size_t)0 : Z_OFF); const int ld = pn < 6 ? 1536 : 512; const int col0 = (pn < 6 ? pn : pn - 6) * BM + wc * 32 + 8 * fq;
#pragma unroll
            for (int ai = 0; ai < 2; ++ai)
#pragma unroll
                for (int m = 0; m < 4; ++m) { const int row = row0 + ai * HALF + m * 16; const float r = rsqrtf(ss[row] * (1.0f / 1024.0f) + RMS_EPS);
#pragma unroll
                    for (int bj = 0; bj < 2; ++bj) { const f32x4 v0 = acc[ai][bj][m][0] * r, v1 = acc[ai][bj][m][1] * r;
                        u32x4 w; w.x = cvt_pk_bf16(v0[0], v0[1]); w.y = cvt_pk_bf16(v0[2], v0[3]); w.z = cvt_pk_bf16(v1[0], v1[1]); w.w = cvt_pk_bf16(v1[2], v1[3]);
                        *(u32x4*)(dst + (size_t)row * ld + col0 + bj * HALF) = w; } }
        } else if (pn < 14) {
            const int sec = (pn - 8) >> 1, head = 4 * ((pn - 8) & 1) + wc;
            bf16_t* dst = qkvb + (size_t)sec * QKVB_STRIDE;
            const float* nw = nwt + sec * 64;
            f32x4 wv[2][2];
#pragma unroll
            for (int bj = 0; bj < 2; ++bj)
#pragma unroll
                for (int n = 0; n < 2; ++n) wv[bj][n] = *(const f32x4*)(nw + 32 * bj + 8 * fq + 4 * n);
#pragma unroll
            for (int ai = 0; ai < 2; ++ai)
#pragma unroll
                for (int m = 0; m < 4; ++m) { const int row = row0 + ai * HALF + m * 16; const float r = rsqrtf(ss[row] * (1.0f / 1024.0f) + RMS_EPS);
                    f32x4 v[2][2]; float s = 0.f;
#pragma unroll
                    for (int bj = 0; bj < 2; ++bj)
#pragma unroll
                        for (int n = 0; n < 2; ++n) { v[bj][n] = acc[ai][bj][m][n] * r; s += (v[bj][n][0] * v[bj][n][0] + v[bj][n][1] * v[bj][n][1]) + (v[bj][n][2] * v[bj][n][2] + v[bj][n][3] * v[bj][n][3]); }
                    s += __shfl_xor(s, 16); s += __shfl_xor(s, 32);
                    const float rn = sec < 2 ? rsqrtf(s * (1.0f / 64.0f) + RMS_EPS) : 1.0f;
#pragma unroll
                    for (int bj = 0; bj < 2; ++bj) { const f32x4 v0 = v[bj][0] * wv[bj][0] * rn, v1 = v[bj][1] * wv[bj][1] * rn;
                        u32x4 w; w.x = cvt_pk_bf16(v0[0], v0[1]); w.y = cvt_pk_bf16(v0[2], v0[3]); w.z = cvt_pk_bf16(v1[0], v1[1]); w.w = cvt_pk_bf16(v1[2], v1[3]);
                        *(u32x4*)(dst + (size_t)row * 512 + head * 64 + 32 * bj + 8 * fq) = w; } }
        } else {
            if (wc == 0 && fq < 2) {
#pragma unroll
                for (int ai = 0; ai < 2; ++ai)
#pragma unroll
                    for (int m = 0; m < 4; ++m) { const int row = row0 + ai * HALF + m * 16; const float r = rsqrtf(ss[row] * (1.0f / 1024.0f) + RMS_EPS);
                        *(f32x4*)(ab + (size_t)row * 16 + 8 * fq) = acc[ai][0][m][0] * r; *(f32x4*)(ab + (size_t)row * 16 + 8 * fq + 4) = acc[ai][0][m][1] * r; }
            }
        }
    }
};

template <class Epi, class Sched, bool ALIGN_EPI = false, bool SP2 = false>
__device__ __forceinline__ void gemm_phase(PG8_LAS unsigned char* lds, const Gemm g, const Sched& S, const Epi& E) {
    const int tid = threadIdx.x, wid = __builtin_amdgcn_readfirstlane(tid >> 6), lane = tid & 63, wr = wid >> 2, wc = wid & 3, fr = lane & 15, fq = lane >> 4;
    const int K = g.K, nt = K / BK;
    unsigned voffA[2], voffB[2];
#pragma unroll
    for (int i = 0; i < 2; ++i) { int R, C; stage_rc(tid * 16 + i * 8192, R, C); const int Rb = Epi::PERM ? ((R & ~31) + perm32(R & 31)) : R;
        voffA[i] = (unsigned)(R * K + C) * 2u; voffB[i] = (unsigned)(Rb * K + C) * 2u; }
    const size_t kstep = (size_t)(BK * 2);
    const size_t hstep = (size_t)HALF * K * 2;
    const size_t tstep = 2 * hstep;
    const unsigned ldsw = (unsigned)wid * 1024u;
    const int aoff = lds_byte(wr * 64 + fr, fq * 8), boff = lds_byte(wc * 32 + fr, fq * 8);
#define PG8_SA(b, h) (((b) * 2 + (h)) * HTB)
#define PG8_SB(b, h) ((4 + (b) * 2 + (h)) * HTB)
#define PG8_STAGE(bufoff, gbase, voff) do { _Pragma("unroll") for (int _i = 0; _i < 2; ++_i) \
        __builtin_amdgcn_global_load_lds((const unsigned*)((const char*)(gbase) + (voff)[_i]), (PG8_LAS unsigned*)(lds + (bufoff) + ldsw + _i * 8192), 16, 0, 0); } while (0)
#define PG8_LDA(dst, b, h) do { _Pragma("unroll") for (int m = 0; m < 4; ++m) _Pragma("unroll") for (int k = 0; k < 2; ++k) dst[m][k] = *(const PG8_LAS bf16x8*)(lds + PG8_SA(b, h) + aoff + m * 2048 + k * 1024); } while (0)
#define PG8_LDB(dst, b, h) do { _Pragma("unroll") for (int n = 0; n < 2; ++n) _Pragma("unroll") for (int k = 0; k < 2; ++k) dst[n][k] = *(const PG8_LAS bf16x8*)(lds + PG8_SB(b, h) + boff + n * 2048 + k * 1024); } while (0)
#define PG8_MMA(ai, bj, At, Bt) do { __builtin_amdgcn_s_setprio(1); _Pragma("unroll") for (int m = 0; m < 4; ++m) _Pragma("unroll") for (int n = 0; n < 2; ++n) _Pragma("unroll") for (int k = 0; k < 2; ++k) \
        acc[ai][bj][m][n] = __builtin_amdgcn_mfma_f32_16x16x32_bf16(Bt[n][k], At[m][k], acc[ai][bj][m][n], 0, 0, 0); __builtin_amdgcn_s_setprio(0); } while (0)
#define PG8_WAIT_V(n) asm volatile("s_waitcnt vmcnt(" #n ")" ::: "memory")
#define PG8_WAIT_L(n) asm volatile("s_waitcnt lgkmcnt(" #n ")" ::: "memory")
#define PG8_BAR __builtin_amdgcn_s_barrier()
#define PG8_SCHED __builtin_amdgcn_sched_barrier(0)
    Unit cur, nxt; int ui = 0;
    if (!S.next(0, cur)) return;
    f32x4 acc[2][2][4][2];
#pragma unroll
    for (int a = 0; a < 2; ++a)
#pragma unroll
        for (int b = 0; b < 2; ++b)
#pragma unroll
            for (int m = 0; m < 4; ++m)
#pragma unroll
                for (int n = 0; n < 2; ++n) acc[a][b][m][n] = (f32x4){0.f, 0.f, 0.f, 0.f};
    bf16x8 At[4][2], B0[2][2], B1[2][2];
    const char* cA = (const char*)g.A + (size_t)cur.pm * tstep; const char* cB = (const char*)g.Bt + (size_t)cur.pn * tstep;
    S.a_ready(cur);
    if constexpr (SP2) {
        PG8_STAGE(PG8_SB(0, 0), cB, voffB); PG8_STAGE(PG8_SB(0, 1), cB + hstep, voffB); PG8_STAGE(PG8_SA(0, 0), cA, voffA); PG8_STAGE(PG8_SA(0, 1), cA + hstep, voffA);
        if (wr == 1) PG8_BAR;
        PG8_WAIT_V(2); PG8_BAR;
        PG8_STAGE(PG8_SB(1, 0), cB + kstep, voffB); PG8_STAGE(PG8_SA(1, 0), cA + kstep, voffA); PG8_STAGE(PG8_SB(1, 1), cB + hstep + kstep, voffB);
        PG8_WAIT_V(6); PG8_BAR;
    } else {
        PG8_STAGE(PG8_SB(0, 0), cB, voffB); PG8_STAGE(PG8_SA(0, 0), cA, voffA); PG8_STAGE(PG8_SB(0, 1), cB + hstep, voffB); PG8_STAGE(PG8_SA(0, 1), cA + hstep, voffA);
        if (wr == 1) PG8_BAR;
        PG8_WAIT_V(4); PG8_BAR;
        PG8_STAGE(PG8_SB(1, 0), cB + kstep, voffB); PG8_STAGE(PG8_SA(1, 0), cA + kstep, voffA); PG8_STAGE(PG8_SB(1, 1), cB + hstep + kstep, voffB);
        PG8_WAIT_V(6); PG8_BAR;
    }
    for (;;) {
        const bool has_next = S.next(ui + 1, nxt);
        const char* nA = has_next ? (const char*)g.A + (size_t)nxt.pm * tstep : cA; const char* nB = has_next ? (const char*)g.Bt + (size_t)nxt.pn * tstep : cB;
        for (int t = 0; t < nt; t += 2) {
            const bool last = (t == nt - 2);
            const char* a1 = cA + (size_t)(t + 1) * kstep;
            const char* a2 = last ? nA : cA + (size_t)(t + 2) * kstep; const char* b2 = last ? nB : cB + (size_t)(t + 2) * kstep;
            const char* a3 = a2 + kstep; const char* b3 = b2 + kstep;
            if (last && has_next) S.a_ready(nxt);
            if constexpr (SP2) {
            PG8_LDB(B0, 0, 0); PG8_LDB(B1, 0, 1); PG8_SCHED; PG8_LDA(At, 0, 0); PG8_STAGE(PG8_SA(1, 1), a1 + hstep, voffA);
            PG8_WAIT_V(8); PG8_WAIT_L(0); PG8_BAR; PG8_MMA(0, 0, At, B0); PG8_MMA(0, 1, At, B1); PG8_BAR; PG8_SCHED;
            PG8_LDA(At, 0, 1); PG8_STAGE(PG8_SB(0, 0), b2, voffB); PG8_STAGE(PG8_SB(0, 1), b2 + hstep, voffB); PG8_STAGE(PG8_SA(0, 0), a2, voffA);
            PG8_WAIT_V(8); PG8_WAIT_L(0); PG8_BAR; PG8_MMA(1, 0, At, B0); PG8_MMA(1, 1, At, B1); PG8_BAR; PG8_SCHED;
            PG8_LDB(B0, 1, 0); PG8_LDB(B1, 1, 1); PG8_SCHED; PG8_LDA(At, 1, 0); PG8_STAGE(PG8_SA(0, 1), a2 + hstep, voffA);
            PG8_WAIT_V(8); PG8_WAIT_L(0); PG8_BAR; PG8_MMA(0, 0, At, B0); PG8_MMA(0, 1, At, B1); PG8_BAR; PG8_SCHED;
            PG8_LDA(At, 1, 1); PG8_STAGE(PG8_SB(1, 0), b3, voffB); PG8_STAGE(PG8_SB(1, 1), b3 + hstep, voffB); PG8_STAGE(PG8_SA(1, 0), a3, voffA);
            PG8_WAIT_V(8); PG8_WAIT_L(0); PG8_BAR; PG8_MMA(1, 0, At, B0); PG8_MMA(1, 1, At, B1); PG8_BAR; PG8_SCHED;
            } else {
            PG8_LDB(B0, 0, 0); PG8_SCHED; PG8_LDA(At, 0, 0); PG8_STAGE(PG8_SA(1, 1), a1 + hstep, voffA);
            PG8_WAIT_L(8); PG8_BAR; PG8_WAIT_L(0); PG8_MMA(0, 0, At, B0); PG8_BAR; PG8_SCHED;
            PG8_LDB(B1, 0, 1); PG8_STAGE(PG8_SB(0, 0), b2, voffB);
            PG8_BAR; PG8_WAIT_L(0); PG8_MMA(0, 1, At, B1); PG8_BAR;
            PG8_LDA(At, 0, 1); PG8_STAGE(PG8_SA(0, 0), a2, voffA);
            PG8_BAR; PG8_WAIT_L(0); PG8_MMA(1, 0, At, B0); PG8_BAR; PG8_SCHED;
            PG8_STAGE(PG8_SB(0, 1), b2 + hstep, voffB);
            PG8_WAIT_V(6); PG8_BAR; PG8_MMA(1, 1, At, B1); PG8_BAR;
            PG8_LDB(B0, 1, 0); PG8_SCHED; PG8_LDA(At, 1, 0); PG8_STAGE(PG8_SA(0, 1), a2 + hstep, voffA);
            PG8_WAIT_L(8); PG8_BAR; PG8_WAIT_L(0); PG8_MMA(0, 0, At, B0); PG8_BAR; PG8_SCHED;
            PG8_LDB(B1, 1, 1); PG8_STAGE(PG8_SB(1, 0), b3, voffB);
            PG8_BAR; PG8_WAIT_L(0); PG8_MMA(0, 1, At, B1); PG8_BAR;
            PG8_LDA(At, 1, 1); PG8_STAGE(PG8_SA(1, 0), a3, voffA);
            PG8_BAR; PG8_WAIT_L(0); PG8_MMA(1, 0, At, B0); PG8_BAR; PG8_SCHED;
            PG8_STAGE(PG8_SB(1, 1), b3 + hstep, voffB);
            PG8_WAIT_V(6); PG8_BAR; PG8_MMA(1, 1, At, B1); PG8_BAR;
            }
        }
        if constexpr (ALIGN_EPI) { if (wr == 0) PG8_BAR; }
        if constexpr (!Epi::AFTER_DRAIN) { E(acc, cur, wr, wc, fr, fq); S.done(cur); }
        if (!has_next) break;
#pragma unroll
        for (int a = 0; a < 2; ++a)
#pragma unroll
            for (int b = 0; b < 2; ++b)
#pragma unroll
                for (int m = 0; m < 4; ++m)
#pragma unroll
                    for (int n = 0; n < 2; ++n) acc[a][b][m][n] = (f32x4){0.f, 0.f, 0.f, 0.f};
        cur = nxt; cA = nA; cB = nB; ++ui;
        if constexpr (ALIGN_EPI) { if (wr == 1) PG8_BAR; }
    }
    PG8_WAIT_V(0);
    if constexpr (!ALIGN_EPI) { if (wr == 0) PG8_BAR; }
    PG8_BAR;
    if constexpr (Epi::AFTER_DRAIN) { E.fused(acc, cur, wr, wc, fr, fq, lds, wid, lane); S.done(cur); }
#undef PG8_SA
#undef PG8_SB
#undef PG8_STAGE
#undef PG8_LDA
#undef PG8_LDB
#undef PG8_MMA
#undef PG8_WAIT_V
#undef PG8_WAIT_L
#undef PG8_BAR
#undef PG8_SCHED
}
}
constexpr int NWAVES = 8;
constexpr int BATCH = 2, SEQ = 8192, D = 1024, FF = 2816, M = BATCH * SEQ;
constexpr int N_IN = 3600, NIN_PAD = 3840, NGU = 2 * FF;
constexpr int GH = 4, GD = 128, GW = 512, AH = 8, AD = 64, AW = 512;
constexpr float EPS = 1e-6f;
constexpr size_t MiB = 1u << 20;
constexpr size_t WS_CTL = 0, CTL_ZERO_BYTES = 1 * MiB;
constexpr size_t WS_SS2 = 256 * 1024, WS_SS3 = 320 * 1024, WS_SS4 = 384 * 1024;
constexpr size_t WS_SS1 = 1 * MiB, WS_NWT = 1 * MiB + 65536;
constexpr size_t WS_WGU1 = 2 * MiB, WS_WD1 = 13 * MiB, WS_WIN = 19 * MiB, WS_WOUT = 27 * MiB, WS_WGU2 = 29 * MiB, WS_WD2 = 40 * MiB;
constexpr size_t WS_XB = 46 * MiB, WS_XB2 = 78 * MiB;
constexpr size_t WS_ACT = 110 * MiB;
constexpr size_t WS_QKVA = 110 * MiB, WS_Z = 158 * MiB, WS_QB = 174 * MiB, WS_KB = 190 * MiB, WS_VB = 206 * MiB, WS_AB = 222 * MiB;
constexpr size_t WS_IF = 29 * MiB, WS_SCAL = 45 * MiB, WS_WF = WS_XB, WS_UC = WS_XB2, WS_QF = 223 * MiB, WS_KT = 239 * MiB;
constexpr size_t WS_AO = WS_QKVA;
constexpr size_t WS_END = 256 * MiB;
constexpr int CW_BAR = 4096;
constexpr int RING_OFF = 0, RING_BYTES = 143360;
constexpr int LDSCTL_OFF = RING_BYTES, MISC_OFF = LDSCTL_OFF + 320;
constexpr int LDS_BYTES = 147456;
#define GAS __attribute__((address_space(1)))
#define LAS __attribute__((address_space(3)))
typedef unsigned short bf16;
typedef unsigned v4u __attribute__((ext_vector_type(4)));
typedef float f32x4 __attribute__((ext_vector_type(4)));
typedef short bf16x8 __attribute__((ext_vector_type(8)));
typedef GAS unsigned gu32;
typedef GAS unsigned long long gu64;
#define RLX_AGENT __ATOMIC_RELAXED, __HIP_MEMORY_SCOPE_AGENT
#define LDS_WAIT() asm volatile("s_waitcnt lgkmcnt(0)" ::: "memory")
#define VM_WAIT() asm volatile("s_waitcnt vmcnt(0)" ::: "memory")
__device__ __forceinline__ unsigned long long rt() { return __builtin_amdgcn_s_memrealtime(); }
__device__ __forceinline__ unsigned f2bf(float f) { unsigned u = __builtin_bit_cast(unsigned, f); return (u + 0x7fffu + ((u >> 16) & 1u)) >> 16; }
__device__ __forceinline__ unsigned pk2(float lo, float hi) { return f2bf(lo) | (f2bf(hi) << 16); }

#define XB_TMO      128
#define XB_XCNT(j)  (256  + 64 * (j))
#define XB_XSUB(j)  (1280 + 64 * (j))
#define XB_XGEN(j)  (2304 + 64 * (j))
#define XB_TOP      3328
#define XB_TOPGEN   3392
#define XCD_BAR_WORDS 3456
#define XB_SPIN_CAP (1u << 18)

__device__ __forceinline__ unsigned xb_ld(unsigned* p)              { return __hip_atomic_load(p, __ATOMIC_RELAXED, __HIP_MEMORY_SCOPE_AGENT); }
__device__ __forceinline__ unsigned xb_add(unsigned* p, unsigned v) { return __hip_atomic_fetch_add(p, v, __ATOMIC_RELAXED, __HIP_MEMORY_SCOPE_AGENT); }
__device__ __forceinline__ unsigned xb_xcc_id() { return (unsigned)__builtin_amdgcn_s_getreg((3 << 11) | 20) & 0xFu; }
#define XB_SPIN(cond, bar) do { unsigned _sp = 0; while (cond) { __builtin_amdgcn_s_sleep(1); \
    if ((++_sp & 255u) == 0u) { if (xb_ld(&(bar)[XB_TMO])) break; if (_sp > XB_SPIN_CAP) { atomicAdd(&(bar)[XB_TMO], 1u); break; } } } } while (0)

struct XcdBarrier {
    unsigned* bar; unsigned x;
    volatile LAS unsigned* st;
};

__device__ __forceinline__ XcdBarrier xcd_barrier_post(unsigned* bar, volatile LAS unsigned* st) {
    XcdBarrier b; b.bar = bar; b.x = xb_xcc_id(); b.st = st;
    if (threadIdx.x == 0) (void)xb_add(&bar[XB_XCNT(b.x)], 1u);
    return b;
}
__device__ __forceinline__ void xcd_barrier_complete(unsigned* bar, unsigned x, unsigned& nloc, unsigned& nx) {
    const unsigned G = gridDim.x * gridDim.y * gridDim.z;
    unsigned sum, cnt, mine, sp = 0u;
    for (;;) {
        sum = 0u; cnt = 0u; mine = 0u;
#pragma unroll
        for (unsigned j = 0; j < 16; ++j) { const unsigned c = xb_ld(&bar[XB_XCNT(j)]); sum += c; cnt += (c > 0u) ? 1u : 0u; mine = (j == x) ? c : mine; }
        if (sum == G) break;
        __builtin_amdgcn_s_sleep(1);
        if ((++sp & 255u) == 0u) { if (xb_ld(&bar[XB_TMO])) break; if (sp > XB_SPIN_CAP) { atomicAdd(&bar[XB_TMO], 1u); break; } }
    }
    nloc = mine > 0u ? mine : 1u; nx = cnt > 0u ? cnt : 1u;
}

__device__ __forceinline__ void xcd_barrier(const XcdBarrier& b) {
    asm volatile("s_waitcnt vmcnt(0)" ::: "memory");
    __syncthreads();
    if (threadIdx.x == 0) {
        unsigned* bar = b.bar;
        __builtin_amdgcn_s_waitcnt(0);
        unsigned nloc = b.st[0], nx = b.st[1];
        if (nloc == 0u) { xcd_barrier_complete(bar, b.x, nloc, nx); b.st[0] = nloc; b.st[1] = nx; }
        const unsigned old = xb_add(&bar[XB_XSUB(b.x)], 1u);
        const unsigned gen = old / nloc;
        if (old + 1u == (gen + 1u) * nloc) {
            __builtin_amdgcn_fence(__ATOMIC_RELEASE, "agent");
            asm volatile("s_waitcnt vmcnt(0)" ::: "memory");
            const unsigned og = xb_add(&bar[XB_TOP], 1u);
            const unsigned tg = og / nx;
            if (og + 1u == (tg + 1u) * nx) xb_add(&bar[XB_TOPGEN], 1u);
            else XB_SPIN(xb_ld(&bar[XB_TOPGEN]) == tg, bar);
            __builtin_amdgcn_fence(__ATOMIC_ACQUIRE, "agent");
            xb_add(&bar[XB_XGEN(b.x)], 1u);
            asm volatile("s_waitcnt vmcnt(0)" ::: "memory");
        } else {
            XB_SPIN(xb_ld(&bar[XB_XGEN(b.x)]) == gen, bar);
            __builtin_amdgcn_fence(__ATOMIC_ACQUIRE, "agent");
            asm volatile("s_waitcnt vmcnt(0)" ::: "memory");
        }
    }
    __syncthreads();
}

struct Args { const float* in[20]; float* out; unsigned char* ws; int ph_lo, ph_hi, li, pad; };
enum { IN_X = 0, IN_FFN1_NORM, IN_WG1, IN_WU1, IN_WD1, IN_MIX_NORM, IN_WIN, IN_CONVW, IN_ALOG, IN_DTBIAS, IN_GDN_NORM, IN_QNORM, IN_KNORM, IN_RELBIAS, IN_WOUT, IN_FFN2_NORM, IN_WG2, IN_WU2, IN_WD2, IN_FINAL_NORM };
struct Frame {
    LAS unsigned char* lds; volatile LAS unsigned* MISC; gu32* ctl;
    int wave, vcu, G;
};
__device__ __forceinline__ float wave_sum(float v) {
#pragma unroll
    for (int o = 1; o < 64; o <<= 1) v += __shfl_xor(v, o);
    return v;
}
__device__ __forceinline__ float bf2f(unsigned short b) { return __builtin_bit_cast(float, (unsigned)b << 16); }

__device__ __forceinline__ void p0_transpose_item(const float* W, int ld, int k0, int n0, int nvalid, const float* scale, bf16* WT, int dstK, int row0, LAS float* scr, int lane) {
    const int c = lane & 31;
#pragma unroll 8
    for (int i = 0; i < 32; ++i) { const int kk = 2 * i + (lane >> 5); float v = (c < nvalid) ? W[(size_t)(k0 + kk) * ld + n0 + c] : 0.f; if (scale) v *= scale[k0 + kk]; scr[kk * 33 + c] = v; }
    LDS_WAIT(); asm volatile("" ::: "memory");
    const int ch = lane & 7;
#pragma unroll
    for (int j = 0; j < 4; ++j) { const int n = (lane >> 3) + 8 * j; const LAS float* s = scr + (8 * ch) * 33 + n;
        v4u o; o.x = pk2(s[0 * 33], s[1 * 33]); o.y = pk2(s[2 * 33], s[3 * 33]); o.z = pk2(s[4 * 33], s[5 * 33]); o.w = pk2(s[6 * 33], s[7 * 33]);
        *(GAS v4u*)(WT + (size_t)(row0 + n) * dstK + k0 + 8 * ch) = o; }
    LDS_WAIT(); asm volatile("" ::: "memory");
}
constexpr int I_GU = (D / 64) * (NGU / 32), I_D = (FF / 64) * (D / 32), I_IN = (D / 64) * (NIN_PAD / 32), I_OUT = (D / 64) * (D / 32);
__device__ __forceinline__ void p0_weight_item(const Args& a, int which, int r, LAS float* scr, int lane) {
    unsigned char* ws = a.ws;
    if (r < I_GU) { const int kb = r / (NGU / 32), nb = r % (NGU / 32), pn = nb >> 3, q = nb & 7;
        const float* src = which ? ((q >> 2) ? a.in[IN_WU2] : a.in[IN_WG2]) : ((q >> 2) ? a.in[IN_WU1] : a.in[IN_WG1]);
        p0_transpose_item(src, FF, 64 * kb, 128 * pn + 32 * (q & 3), 32, (which ? a.in[IN_FFN2_NORM] : a.in[IN_FFN1_NORM]), (bf16*)(ws + (which ? WS_WGU2 : WS_WGU1)), D, 32 * nb, scr, lane); return; }
    r -= I_GU;
    if (r < I_D) { const int kb = r / (D / 32), nb = r % (D / 32);
        p0_transpose_item((which ? a.in[IN_WD2] : a.in[IN_WD1]), D, 64 * kb, 32 * nb, 32, nullptr, (bf16*)(ws + (which ? WS_WD2 : WS_WD1)), FF, 32 * nb, scr, lane); return; }
    r -= I_D;
    if (r < I_IN) { const int kb = r / (NIN_PAD / 32), nb = r % (NIN_PAD / 32), pn = nb >> 3, q = nb & 7; int n0 = 32 * nb, nvalid = 32;
        if (pn >= 14) { n0 = 2048; nvalid = (q == 0) ? 16 : 0; }
        else if (pn >= 8) { const int sec = (pn - 8) >> 1, half = (pn - 8) & 1, bj = q >> 2, wc = q & 3; n0 = 2064 + sec * 512 + (4 * half + wc) * 64 + 32 * bj; }
        p0_transpose_item(a.in[IN_WIN], N_IN, 64 * kb, n0, nvalid, a.in[IN_MIX_NORM], (bf16*)(ws + WS_WIN), D, 32 * nb, scr, lane); return; }
    r -= I_IN;
    { const int kb = r / (D / 32), nb = r % (D / 32);
        p0_transpose_item(a.in[IN_WOUT], D, 64 * kb, 32 * nb, 32, nullptr, (bf16*)(ws + WS_WOUT), D, 32 * nb, scr, lane); }
}
__device__ __forceinline__ void x_row_to_bf16(const float* xrow, bf16* orow, float* ssp, int lane) {
    const GAS f32x4* xr = (const GAS f32x4*)xrow + lane;
    f32x4 v[4]; float s = 0.f;
#pragma unroll
    for (int j = 0; j < 4; ++j) { v[j] = xr[64 * j]; s += (v[j].x * v[j].x + v[j].y * v[j].y) + (v[j].z * v[j].z + v[j].w * v[j].w); }
    s = wave_sum(s);
    GAS unsigned long long* o8 = (GAS unsigned long long*)orow + lane;
#pragma unroll
    for (int j = 0; j < 4; ++j) o8[64 * j] = (unsigned long long)pk2(v[j].x, v[j].y) | ((unsigned long long)pk2(v[j].z, v[j].w) << 32);
    if (lane == 0) *ssp = s;
}
__device__ __forceinline__ void final_norm_row(float* row, const float* w, float ss, int lane) {
    const float r = rsqrtf(ss * (1.0f / D) + EPS);
    GAS f32x4* p = (GAS f32x4*)row + lane; const GAS f32x4* wp = (const GAS f32x4*)w + lane;
#pragma unroll
    for (int j = 0; j < 4; ++j) { f32x4 v = p[64 * j]; const f32x4 ww = wp[64 * j]; v = v * ww * r; p[64 * j] = v; }
}


namespace gdn {
typedef float f32x16 __attribute__((ext_vector_type(16)));
typedef float f32x4 __attribute__((ext_vector_type(4)));
typedef short bf16x8 __attribute__((ext_vector_type(8)));
typedef unsigned u32x4 __attribute__((ext_vector_type(4)));
typedef unsigned u32x2 __attribute__((ext_vector_type(2)));
constexpr int TS = 72;
constexpr int L_QS = 0, L_KS = 16384, L_KT = 32768, L_VT = 51200, L_LM = 69632, L_G = 106496, L_END = 108544;
constexpr int LM_BYTES = 18432;
typedef float f32x2_t __attribute__((ext_vector_type(2))); typedef __bf16 bf16x2_t __attribute__((ext_vector_type(2)));
__device__ __forceinline__ unsigned pkbf(float lo, float hi) { f32x2_t v = {lo, hi}; bf16x2_t b = __builtin_convertvector(v, bf16x2_t); return __builtin_bit_cast(unsigned, b); }
__device__ __forceinline__ bf16x8 pack8(const f32x16& x, int b) { u32x4 w; w.x = pkbf(x[b], x[b + 1]); w.y = pkbf(x[b + 2], x[b + 3]); w.z = pkbf(x[b + 4], x[b + 5]); w.w = pkbf(x[b + 6], x[b + 7]); return __builtin_bit_cast(bf16x8, w); }
__device__ __forceinline__ float lo2f(unsigned u) { return __builtin_bit_cast(float, u << 16); }
__device__ __forceinline__ float hi2f(unsigned u) { return __builtin_bit_cast(float, u & 0xffff0000u); }
__device__ __forceinline__ f32x16 mfma32(bf16x8 a, bf16x8 b, f32x16 c) { return __builtin_amdgcn_mfma_f32_32x32x16_bf16(a, b, c, 0, 0, 0); }
__device__ __forceinline__ int crow(int r, int hh) { return (r & 3) + 8 * (r >> 2) + 4 * hh; }
__device__ __forceinline__ int qk_off(int row, int d) { return row * 256 + ((((d >> 3) ^ (row & 15)) << 4) | ((d & 7) << 1)); }

struct Bufs { const bf16* qkva; const float* ab; bf16* Qf; bf16* Kt; bf16* Wf; bf16* If; bf16* Uc; float* Scal; unsigned* dbg; };
#ifdef GDN_DBG
#define DBGMAX(k, v) atomicMax(B.dbg + (k), __float_as_uint(v) & 0x7fffffffu)
#else
#define DBGMAX(k, v) do {} while (0)
#endif

__device__ __forceinline__ void prep_item(LAS unsigned char* lds, const Bufs& B, const float* conv_w, const float* a_log, const float* dt_bias, int bh, int c, int wave, int lane_in) {
    int lane = lane_in; asm volatile("" : "+v"(lane));
    const int b = bh >> 2, h = bh & 3, t0 = 64 * c;
    {
        const bf16* src = B.qkva + (size_t)b * SEQ * 1536 + h * 128 + 2 * lane;
        float wq[3][2][5];
#pragma unroll
        for (int sec = 0; sec < 3; ++sec)
#pragma unroll
            for (int e = 0; e < 2; ++e)
#pragma unroll
                for (int j = 0; j < 5; ++j) wq[sec][e][j] = conv_w[(size_t)(sec * 512 + h * 128 + 2 * lane + e) * 5 + j];
        float xin[3][12][2];
#pragma unroll
        for (int rr = 0; rr < 12; ++rr) { const int t = t0 + 8 * wave - 2 + rr; const bool ok = (t >= 0) && (t < SEQ);
#pragma unroll
            for (int sec = 0; sec < 3; ++sec) { const unsigned u = ok ? *(const unsigned*)(src + (size_t)t * 1536 + sec * 512) : 0u; xin[sec][rr][0] = lo2f(u); xin[sec][rr][1] = hi2f(u); } }
        unsigned ktp[2][4], vtp[2][4];
#pragma unroll
        for (int i = 0; i < 8; ++i) {
            float o[3][2];
#pragma unroll
            for (int sec = 0; sec < 3; ++sec)
#pragma unroll
                for (int e = 0; e < 2; ++e) { float s = 0.f;
#pragma unroll
                    for (int j = 0; j < 5; ++j) s += xin[sec][i + j][e] * wq[sec][e][j];
                    o[sec][e] = s / (1.f + __expf(-s)); }
            const float sq = wave_sum(o[0][0] * o[0][0] + o[0][1] * o[0][1]), sk = wave_sum(o[1][0] * o[1][0] + o[1][1] * o[1][1]);
            const float rq = rsqrtf(sq + EPS) * 0.08838834764831845f, rk = rsqrtf(sk + EPS);
            const int row = 8 * wave + i;
            *(LAS unsigned*)(lds + L_QS + qk_off(row, 2 * lane)) = pkbf(o[0][0] * rq, o[0][1] * rq);
            const unsigned kp = pkbf(o[1][0] * rk, o[1][1] * rk), vp = pkbf(o[2][0], o[2][1]);
            *(LAS unsigned*)(lds + L_KS + qk_off(row, 2 * lane)) = kp;
            if (i & 1) { ktp[0][i >> 1] |= kp << 16; ktp[1][i >> 1] |= kp & 0xffff0000u; vtp[0][i >> 1] |= vp << 16; vtp[1][i >> 1] |= vp & 0xffff0000u; }
            else { ktp[0][i >> 1] = kp & 0xffffu; ktp[1][i >> 1] = kp >> 16; vtp[0][i >> 1] = vp & 0xffffu; vtp[1][i >> 1] = vp >> 16; }
        }
#pragma unroll
        for (int e = 0; e < 2; ++e) {
            *(LAS u32x4*)(lds + L_KT + ((2 * lane + e) * TS + 8 * wave) * 2) = (u32x4){ktp[e][0], ktp[e][1], ktp[e][2], ktp[e][3]};
            *(LAS u32x4*)(lds + L_VT + ((2 * lane + e) * TS + 8 * wave) * 2) = (u32x4){vtp[e][0], vtp[e][1], vtp[e][2], vtp[e][3]};
        }
    }
    if (wave < 2) {
        const int dir = wave, t = t0 + lane; const float* abr = B.ab + ((size_t)b * SEQ + t) * 16;
        const float a = abr[dir * 4 + h] + dt_bias[dir * 4 + h];
        const float sp = (a > 20.f) ? a : log1pf(expf(a));
        float G = -expf(a_log[dir * 4 + h]) * sp;
        const float beta = 1.f / (1.f + expf(-abr[8 + dir * 4 + h]));
        if (dir == 0) {
#pragma unroll
            for (int o = 1; o < 64; o <<= 1) { const float n = __shfl_up(G, o); if (lane >= o) G += n; }
        } else {
#pragma unroll
            for (int o = 1; o < 64; o <<= 1) { const float n = __shfl_down(G, o); if (lane + o < 64) G += n; }
        }
        const float Gl = __shfl(G, dir ? 0 : 63);
        LAS float* gs = (LAS float*)(lds + L_G) + dir * 256;
        gs[lane] = G; gs[64 + lane] = beta; gs[128 + lane] = __expf(G); gs[192 + lane] = __expf(Gl - G);
        float* sc = B.Scal + ((size_t)(bh * 2 + dir) * 128 + c) * 128;
        sc[lane] = __expf(G); sc[64 + lane] = __expf(Gl - G);
    }
    LDS_WAIT(); __syncthreads();
    {
        asm volatile("" : "+v"(lane)); const int r32 = lane & 31, hh = lane >> 5;
        const bool isKK = wave < 4; const int ta = (wave >> 1) & 1, tb = wave & 1;
        f32x16 acc = {};
#pragma unroll
        for (int ks = 0; ks < 8; ++ks) {
            const bf16x8 av = *(const LAS bf16x8*)(lds + L_KS + qk_off(32 * ta + r32, 16 * ks + 8 * hh));
            const bf16x8 bv = *(const LAS bf16x8*)(lds + (isKK ? L_KS : L_QS) + qk_off(32 * tb + r32, 16 * ks + 8 * hh));
            acc = mfma32(av, bv, acc);
        }
        const LAS float* g0 = (const LAS float*)(lds + L_G); const LAS float* g1 = g0 + 256;
        const int col = 32 * tb + r32;
        if (isKK) {
            const float G0j = g0[col], G1j = g1[col];
            LAS float* L0 = (LAS float*)(lds + L_LM); LAS float* L1 = (LAS float*)(lds + L_LM + LM_BYTES);
#pragma unroll
            for (int r = 0; r < 16; ++r) { const int i = 32 * ta + crow(r, hh);
                if (i > col) L0[i * TS + col] = g0[64 + i] * acc[r] * __expf(g0[i] - G0j);
                if (i < col) L1[(63 - i) * TS + (63 - col)] = g1[64 + i] * acc[r] * __expf(g1[i] - G1j); }
        } else {
            const float G0i = g0[col], G1i = g1[col];
            f32x16 v0, v1;
#pragma unroll
            for (int r = 0; r < 16; ++r) { const int j = 32 * ta + crow(r, hh);
                v0[r] = (col >= j) ? acc[r] * __expf(G0i - g0[j]) : 0.f;
                v1[r] = (col <= j) ? acc[r] * __expf(G1i - g1[j]) : 0.f; }
#pragma unroll
            for (int s = 0; s < 2; ++s) {
                *(bf16x8*)(B.If + ((((size_t)(bh * 2 + 0) * 128 + c) * 2 + tb) * 4 + 2 * ta + s) * 512 + lane * 8) = pack8(v0, 8 * s);
                *(bf16x8*)(B.If + ((((size_t)(bh * 2 + 1) * 128 + c) * 2 + tb) * 4 + 2 * ta + s) * 512 + lane * 8) = pack8(v1, 8 * s);
            }
        }
    }
    LDS_WAIT(); __syncthreads();
    {
        asm volatile("" : "+v"(lane));
        const int dir = wave >> 2, col = 16 * (wave & 3) + (lane >> 2), q = lane & 3;
        const LAS float* Lm = (const LAS float*)(lds + L_LM + dir * LM_BYTES);
        float T[16];
#pragma unroll
        for (int m = 0; m < 16; ++m) T[m] = 0.f;
        if (q == 0) T[0] = (col == 0) ? 1.f : 0.f;
#pragma unroll
        for (int p = 1; p < 64; ++p) {
            float a = 0.f;
#pragma unroll
            for (int m = 0; m < (p + 3) / 4; ++m) { float lv = Lm[p * TS + 4 * m + q]; if (4 * m + 3 >= p) lv = (4 * m + q < p) ? lv : 0.f; a -= lv * T[m]; }
            a += __shfl_xor(a, 1); a += __shfl_xor(a, 2);
            if (q == (p & 3)) T[p >> 2] = a + ((col == p) ? 1.f : 0.f);
        }
        const LAS float* gs = (const LAS float*)(lds + L_G) + dir * 256;
        const int j = dir ? 63 - col : col;
        const float bj = gs[64 + j], bej = bj * gs[128 + j];
        LDS_WAIT(); __syncthreads();
        LAS bf16* Tu = (LAS bf16*)(lds + L_LM + dir * LM_BYTES); LAS bf16* Tw = Tu + 64 * TS;
#pragma unroll
        for (int m = 0; m < 16; ++m) { const int p = 4 * m + q, i = dir ? 63 - p : p; Tu[i * TS + j] = (bf16)f2bf(T[m] * bj); Tw[i * TS + j] = (bf16)f2bf(T[m] * bej); }
    }
#pragma unroll 1
    for (int f = wave; f < 32; f += 8) {
        asm volatile("" : "+v"(lane)); const int r32 = lane & 31, hh = lane >> 5;
        const bool isK = f >= 16; const int ff = f & 15;
        if (!isK) { const int mt = ff >> 3, ks = ff & 7, row = 32 * mt + r32;
            const u32x2 lo = *(const LAS u32x2*)(lds + L_QS + qk_off(row, 16 * ks + 4 * hh)), hi = *(const LAS u32x2*)(lds + L_QS + qk_off(row, 16 * ks + 8 + 4 * hh));
            *(u32x4*)(B.Qf + ((((size_t)bh * 128 + c) * 2 + mt) * 8 + ks) * 512 + lane * 8) = (u32x4){lo.x, lo.y, hi.x, hi.y};
        } else { const int mt = ff >> 2, ks = ff & 3, row = 32 * mt + r32;
            const u32x2 lo = *(const LAS u32x2*)(lds + L_KT + (row * TS + 16 * ks + 4 * hh) * 2), hi = *(const LAS u32x2*)(lds + L_KT + (row * TS + 16 * ks + 8 + 4 * hh) * 2);
            *(u32x4*)(B.Kt + ((((size_t)bh * 128 + c) * 4 + mt) * 4 + ks) * 512 + lane * 8) = (u32x4){lo.x, lo.y, hi.x, hi.y};
        }
    }
    LDS_WAIT(); __syncthreads();
#pragma unroll 1
    for (int k4 = 0; k4 < 4; ++k4) {
        asm volatile("" : "+v"(lane)); const int r32 = lane & 31, hh = lane >> 5;
        const int tt = wave * 4 + k4, dir = tt >> 4, kind = (tt >> 3) & 1, idx = tt & 7;
        const LAS unsigned char* Tu = lds + L_LM + dir * LM_BYTES; const LAS unsigned char* Tw = Tu + 64 * TS * 2;
        const size_t SC = (size_t)(bh * 2 + dir) * 128 + c;
        f32x16 acc = {};
        if (kind == 0) { const int mt = idx >> 2, dvt = idx & 3;
#pragma unroll
            for (int ks = 0; ks < 4; ++ks) { const bf16x8 a_ = *(const LAS bf16x8*)(Tu + ((32 * mt + r32) * TS + 16 * ks + 8 * hh) * 2), b_ = *(const LAS bf16x8*)(lds + L_VT + ((32 * dvt + r32) * TS + 16 * ks + 8 * hh) * 2);
#ifdef GDN_DBG
                for (int e_ = 0; e_ < 8; ++e_) { DBGMAX(0, bf2f((unsigned short)a_[e_])); DBGMAX(1, bf2f((unsigned short)b_[e_])); }
#endif
                acc = mfma32(a_, b_, acc); }
#ifdef GDN_DBG
            for (int e_ = 0; e_ < 16; ++e_) DBGMAX(2, acc[e_]);
#endif
            bf16* dst = B.Uc + ((SC * 4 + dvt) * 2 + mt) * 1024 + lane * 16;
            *(bf16x8*)dst = pack8(acc, 0); *(bf16x8*)(dst + 8) = pack8(acc, 8);
        } else { const int mtk = idx >> 1, ti = idx & 1;
#pragma unroll
            for (int ks = 0; ks < 4; ++ks) acc = mfma32(*(const LAS bf16x8*)(lds + L_KT + ((32 * mtk + r32) * TS + 16 * ks + 8 * hh) * 2), *(const LAS bf16x8*)(Tw + ((32 * ti + r32) * TS + 16 * ks + 8 * hh) * 2), acc);
#pragma unroll
            for (int s = 0; s < 2; ++s) *(bf16x8*)(B.Wf + (((SC * 2 + ti) * 8) + 2 * mtk + s) * 512 + lane * 8) = pack8(acc, 8 * s);
        }
    }
    LDS_WAIT(); __syncthreads();
}

__device__ __forceinline__ void scan_wave(const Bufs& B, int sq, int sl, int lane_in) {
    const int bh = sq >> 1, dir = sq & 1; int lane = lane_in;
    f32x16 S[4] = {};
#pragma unroll 1
    for (int step = 0; step < 128; ++step) {
        asm volatile("" : "+v"(lane)); const int hh = lane >> 5;
        const int c = dir ? 127 - step : step;
        const size_t SC = (size_t)sq * 128 + c, bhc = (size_t)bh * 128 + c;
        const float* sc = B.Scal + SC * 128;
        const unsigned lo16 = (unsigned)lane * 16u;
        const char* wfb = (const char*)(B.Wf + SC * 8192); const char* qfb = (const char*)(B.Qf + bhc * 8192); const char* ifb = (const char*)(B.If + SC * 4096); const char* ktb = (const char*)(B.Kt + bhc * 8192);
        char* ucb = (char*)(B.Uc + (SC * 4 + sl) * 2048);
        f32x16 Pw[2] = {}, Pq[2] = {};
#pragma unroll
        for (int ks = 0; ks < 8; ++ks) {
            const bf16x8 sb = pack8(S[ks >> 1], 8 * (ks & 1));
#pragma unroll
            for (int mt = 0; mt < 2; ++mt) {
                Pw[mt] = mfma32(*(const bf16x8*)(wfb + (mt * 8 + ks) * 1024 + lo16), sb, Pw[mt]);
                Pq[mt] = mfma32(*(const bf16x8*)(qfb + (mt * 8 + ks) * 1024 + lo16), sb, Pq[mt]);
            }
            if ((ks & 1) == 1) { asm volatile("" ::: "memory"); __builtin_amdgcn_sched_barrier(0); }
        }
        bf16x8 Vb[4], Vs[4];
#pragma unroll
        for (int mt = 0; mt < 2; ++mt) {
            const char* up = ucb + mt * 2048 + 2 * lo16;
            const u32x4 u0 = *(const u32x4*)up, u1 = *(const u32x4*)(up + 16);
            const unsigned uu[8] = {u0.x, u0.y, u0.z, u0.w, u1.x, u1.y, u1.z, u1.w};
            f32x16 vs;
#pragma unroll
            for (int g = 0; g < 4; ++g) {
                const f32x4 ek = *(const f32x4*)(sc + 64 + 32 * mt + 8 * g + 4 * hh);
#pragma unroll
                for (int e = 0; e < 4; ++e) { const int r = 4 * g + e; const float u = (r & 1) ? hi2f(uu[r >> 1]) : lo2f(uu[r >> 1]); Pw[mt][r] = u - Pw[mt][r]; vs[r] = Pw[mt][r] * ek[e]; }
            }
            Vb[2 * mt] = pack8(Pw[mt], 0); Vb[2 * mt + 1] = pack8(Pw[mt], 8); Vs[2 * mt] = pack8(vs, 0); Vs[2 * mt + 1] = pack8(vs, 8);
            asm volatile("" ::: "memory"); __builtin_amdgcn_sched_barrier(0);
        }
#pragma unroll
        for (int mt = 0; mt < 2; ++mt) {
#pragma unroll
            for (int g = 0; g < 4; ++g) { const f32x4 eg = *(const f32x4*)(sc + 32 * mt + 8 * g + 4 * hh);
#pragma unroll
                for (int e = 0; e < 4; ++e) Pq[mt][4 * g + e] *= eg[e]; }
#pragma unroll
            for (int ks = 0; ks < 4; ++ks) Pq[mt] = mfma32(*(const bf16x8*)(ifb + (mt * 4 + ks) * 1024 + lo16), Vb[ks], Pq[mt]);
            char* up = ucb + mt * 2048 + 2 * lo16;
            *(bf16x8*)up = pack8(Pq[mt], 0); *(bf16x8*)(up + 16) = pack8(Pq[mt], 8);
            asm volatile("" ::: "memory"); __builtin_amdgcn_sched_barrier(0);
        }
        const float a = sc[dir ? 0 : 63];
#pragma unroll
        for (int T = 0; T < 4; ++T) {
            S[T] = S[T] * a;
#pragma unroll
            for (int ks = 0; ks < 4; ++ks) S[T] = mfma32(*(const bf16x8*)(ktb + (T * 4 + ks) * 1024 + lo16), Vs[ks], S[T]);
            if (T & 1) { asm volatile("" ::: "memory"); __builtin_amdgcn_sched_barrier(0); }
        }
    }
}

constexpr int SL_WF = 0, SL_KT = 16384, SL_UC = 32768, SL_SC = 36864, SLOT_BYTES = 37888, NPIECE = 37, XCH_OFF = 3 * SLOT_BYTES, XCH_BYTES = 12288, SCAN_LDS_END = XCH_OFF + 2 * XCH_BYTES;
static_assert(SCAN_LDS_END <= RING_BYTES, "scan LDS map");
#define SCAN_BAR() do { asm volatile("s_waitcnt lgkmcnt(0)" ::: "memory"); __builtin_amdgcn_s_barrier(); asm volatile("" ::: "memory"); } while (0)
__device__ __forceinline__ void scan_issue(LAS unsigned char* slot, const Bufs& B, int sq, int sl, int c, int wave, unsigned lo16) {
    const int bh = sq >> 1; const size_t SC = (size_t)sq * 128 + c, bhc = (size_t)bh * 128 + c;
    const char* wfb = (const char*)(B.Wf + SC * 8192); const char* ktb = (const char*)(B.Kt + bhc * 8192); const char* ucb = (const char*)(B.Uc + (SC * 4 + sl) * 2048); const char* scb = (const char*)(B.Scal + SC * 128);
#pragma unroll
    for (int k = 0; k < 7; ++k) { const int p = wave - 2 + 6 * k;
        if (p < NPIECE) { const char* src = p < 16 ? wfb + p * 1024 : (p < 32 ? ktb + (p - 16) * 1024 : (p < 36 ? ucb + (p - 32) * 1024 : scb));
            const int off = p < 16 ? SL_WF + p * 1024 : (p < 32 ? SL_KT + (p - 16) * 1024 : (p < 36 ? SL_UC + (p - 32) * 1024 : SL_SC));
            __builtin_amdgcn_global_load_lds((const unsigned*)(src + lo16), (LAS unsigned*)(slot + off), 16, 0, 0); } }
}
__device__ __forceinline__ void scan_wg(LAS unsigned char* lds, const Bufs& B, int sq, int sl, int wave, int lane_in) {
    const int dir = sq & 1, bh = sq >> 1; int lane = lane_in;
#define SCAN_C(s_) (dir ? 127 - (s_) : (s_))
    if (wave >= 2) {
        const unsigned lo16 = (unsigned)lane * 16u;
        scan_issue(lds, B, sq, sl, SCAN_C(0), wave, lo16); scan_issue(lds + SLOT_BYTES, B, sq, sl, SCAN_C(1), wave, lo16);
#pragma unroll 1
        for (int s = 0; s <= 128; ++s) {
            if (s < 127) { if (wave == 2) asm volatile("s_waitcnt vmcnt(7)" ::: "memory"); else asm volatile("s_waitcnt vmcnt(6)" ::: "memory"); }
            else asm volatile("s_waitcnt vmcnt(0)" ::: "memory");
            SCAN_BAR();
            if (s + 2 < 128) { const int sl3 = (s + 2) % 3; scan_issue(lds + sl3 * SLOT_BYTES, B, sq, sl, SCAN_C(s + 2), wave, lo16); }
        }
        return;
    }
    if (wave == 1) {
        bf16x8 qf[16], itf[8]; f32x4 eg[8];
        const unsigned lo16 = (unsigned)lane * 16u; const int hh = lane >> 5;
#define O_LOAD(s_) do { const int c_ = SCAN_C(s_); const size_t SC_ = (size_t)sq * 128 + c_, bhc_ = (size_t)bh * 128 + c_; \
            const char* qfb_ = (const char*)(B.Qf + bhc_ * 8192); const char* ifb_ = (const char*)(B.If + SC_ * 4096); const float* sc_ = B.Scal + SC_ * 128; \
            _Pragma("unroll") for (int i_ = 0; i_ < 16; ++i_) qf[i_] = *(const bf16x8*)(qfb_ + i_ * 1024 + lo16); \
            _Pragma("unroll") for (int i_ = 0; i_ < 8; ++i_) itf[i_] = *(const bf16x8*)(ifb_ + i_ * 1024 + lo16); \
            _Pragma("unroll") for (int i_ = 0; i_ < 8; ++i_) eg[i_] = *(const f32x4*)(sc_ + 32 * (i_ >> 2) + 8 * (i_ & 3) + 4 * hh); } while (0)
        O_LOAD(0);
#pragma unroll 1
        for (int s = 0; s <= 128; ++s) {
            SCAN_BAR();
            if (s == 0) continue;
            const LAS unsigned char* xch = lds + XCH_OFF + ((s - 1) & 1) * XCH_BYTES;
            f32x16 Pq[2] = {};
#pragma unroll
            for (int ks = 0; ks < 8; ++ks) { const bf16x8 sb = *(const LAS bf16x8*)(xch + ks * 1024 + lo16);
#pragma unroll
                for (int mt = 0; mt < 2; ++mt) Pq[mt] = mfma32(qf[mt * 8 + ks], sb, Pq[mt]); }
            bf16x8 Vb[4];
#pragma unroll
            for (int ks = 0; ks < 4; ++ks) Vb[ks] = *(const LAS bf16x8*)(xch + 8192 + ks * 1024 + lo16);
            char* ucg = (char*)(B.Uc + (((size_t)sq * 128 + SCAN_C(s - 1)) * 4 + sl) * 2048);
#pragma unroll
            for (int mt = 0; mt < 2; ++mt) {
#pragma unroll
                for (int g = 0; g < 4; ++g)
#pragma unroll
                    for (int e = 0; e < 4; ++e) Pq[mt][4 * g + e] *= eg[mt * 4 + g][e];
#pragma unroll
                for (int ks = 0; ks < 4; ++ks) Pq[mt] = mfma32(itf[mt * 4 + ks], Vb[ks], Pq[mt]);
                char* up = ucg + mt * 2048 + 2 * lo16;
                *(bf16x8*)up = pack8(Pq[mt], 0); *(bf16x8*)(up + 16) = pack8(Pq[mt], 8);
            }
            if (s < 128) O_LOAD(s);
        }
#undef O_LOAD
        return;
    }
    f32x16 S[4] = {};
#pragma unroll 1
    for (int step = 0; step <= 128; ++step) {
        SCAN_BAR();
        if (step == 128) break;
        LAS unsigned char* slot = lds + (step % 3) * SLOT_BYTES;
        LAS unsigned char* xch = lds + XCH_OFF + (step & 1) * XCH_BYTES;
        asm volatile("" : "+v"(lane)); const int hh = lane >> 5;
        const unsigned lo16 = (unsigned)lane * 16u;
        const LAS float* sc = (const LAS float*)(slot + SL_SC);
        f32x16 Pw[2] = {};
#pragma unroll
        for (int ks = 0; ks < 8; ++ks) {
            const bf16x8 sb = pack8(S[ks >> 1], 8 * (ks & 1));
            *(LAS bf16x8*)(xch + ks * 1024 + lo16) = sb;
#pragma unroll
            for (int mt = 0; mt < 2; ++mt) Pw[mt] = mfma32(*(const LAS bf16x8*)(slot + SL_WF + (mt * 8 + ks) * 1024 + lo16), sb, Pw[mt]);
        }
        const float a = sc[dir ? 0 : 63];
#pragma unroll
        for (int T = 0; T < 4; ++T) S[T] = S[T] * a;
        bf16x8 Vs[4];
#pragma unroll
        for (int mt = 0; mt < 2; ++mt) {
            const LAS unsigned char* up = slot + SL_UC + mt * 2048 + 2 * lo16;
            const u32x4 u0 = *(const LAS u32x4*)up, u1 = *(const LAS u32x4*)(up + 16);
            const unsigned uu[8] = {u0.x, u0.y, u0.z, u0.w, u1.x, u1.y, u1.z, u1.w};
            f32x16 vs;
#pragma unroll
            for (int g = 0; g < 4; ++g) {
                const f32x4 ek = *(const LAS f32x4*)(sc + 64 + 32 * mt + 8 * g + 4 * hh);
#pragma unroll
                for (int e = 0; e < 4; ++e) { const int r = 4 * g + e; const float u = (r & 1) ? hi2f(uu[r >> 1]) : lo2f(uu[r >> 1]); Pw[mt][r] = u - Pw[mt][r]; vs[r] = Pw[mt][r] * ek[e]; }
            }
            *(LAS bf16x8*)(xch + 8192 + (2 * mt) * 1024 + lo16) = pack8(Pw[mt], 0); *(LAS bf16x8*)(xch + 8192 + (2 * mt + 1) * 1024 + lo16) = pack8(Pw[mt], 8);
            Vs[2 * mt] = pack8(vs, 0); Vs[2 * mt + 1] = pack8(vs, 8);
        }
#pragma unroll
        for (int T = 0; T < 4; ++T)
#pragma unroll
            for (int ks = 0; ks < 4; ++ks) S[T] = mfma32(*(const LAS bf16x8*)(slot + SL_KT + (T * 4 + ks) * 1024 + lo16), Vs[ks], S[T]);
    }
#undef SCAN_C
}

__device__ __forceinline__ void finalize_item(const Bufs& B, const bf16* Z, const float* nw, bf16* XBo, int item, int lane) {
    const int Tt = item & 1, c = (item >> 1) & 127, bh = item >> 8, b = bh >> 2, h = bh & 3, r32 = lane & 31, hh = lane >> 5;
    float o[4][16];
#pragma unroll
    for (int sl = 0; sl < 4; ++sl) {
        const bf16* p0 = B.Uc + ((((size_t)(bh * 2 + 0) * 128 + c) * 4 + sl) * 2 + Tt) * 1024 + lane * 16;
        const bf16* p1 = B.Uc + ((((size_t)(bh * 2 + 1) * 128 + c) * 4 + sl) * 2 + Tt) * 1024 + lane * 16;
        const u32x4 a0 = *(const u32x4*)p0, a1 = *(const u32x4*)(p0 + 8), b0 = *(const u32x4*)p1, b1 = *(const u32x4*)(p1 + 8);
        const unsigned ua[8] = {a0.x, a0.y, a0.z, a0.w, a1.x, a1.y, a1.z, a1.w}, ub[8] = {b0.x, b0.y, b0.z, b0.w, b1.x, b1.y, b1.z, b1.w};
#pragma unroll
        for (int r = 0; r < 16; ++r) o[sl][r] = ((r & 1) ? hi2f(ua[r >> 1]) : lo2f(ua[r >> 1])) + ((r & 1) ? hi2f(ub[r >> 1]) : lo2f(ub[r >> 1]));
    }
    float nwv[4];
#pragma unroll
    for (int sl = 0; sl < 4; ++sl) nwv[sl] = nw[32 * sl + r32];
    const size_t rowb = (size_t)b * SEQ + 64 * c + 32 * Tt + 4 * hh;
#pragma unroll
    for (int r = 0; r < 16; ++r) {
        float s = (o[0][r] * o[0][r] + o[1][r] * o[1][r]) + (o[2][r] * o[2][r] + o[3][r] * o[3][r]);
#pragma unroll
        for (int m = 1; m < 32; m <<= 1) s += __shfl_xor(s, m);
        const float rn = rsqrtf(s * (1.0f / 128.0f) + EPS);
        const size_t row = rowb + (r & 3) + 8 * (r >> 2);
        const bf16* zp = Z + row * 512 + h * 128 + r32; bf16* xp = XBo + row * D + h * 128 + r32;
#pragma unroll
        for (int sl = 0; sl < 4; ++sl) { const float z = bf2f(zp[32 * sl]); xp[32 * sl] = (bf16)f2bf(o[sl][r] * rn * nwv[sl] * (z / (1.f + __expf(-z)))); }
        if ((r & 1) == 1) asm volatile("" ::: "memory");
    }
}
}

namespace attn {
using gdn::f32x16; using gdn::bf16x8; using gdn::mfma32; using gdn::pack8; using gdn::crow; using gdn::f32x4; using gdn::u32x4;
typedef short s16x4 __attribute__((ext_vector_type(4)));
constexpr int A_OACC = 0, A_L = 65536, A_BIAS = 66560, A_V = 68608, A_END = A_V + 8 * 8192;
__device__ const unsigned char BUCKET[3][129] = {
 {11,11,11,11,11,11,11,11,11,11,11,11,11,11,11,10,10,10,10,10,10,10,10,10,10,10,10,10,10,10,10,10,10,10,10,10,10,10,9,9,9,9,9,9,9,9,9,9,9,9,8,8,8,8,8,8,8,7,6,5,4,3,2,1,0,17,18,19,20,21,22,23,24,24,24,24,24,24,24,25,25,25,25,25,25,25,25,25,25,25,25,26,26,26,26,26,26,26,26,26,26,26,26,26,26,26,26,26,26,26,26,26,26,26,27,27,27,27,27,27,27,27,27,27,27,27,27,27,27},
 {13,13,13,13,13,13,13,13,13,13,13,13,13,13,13,13,13,13,13,13,13,13,13,12,12,12,12,12,12,12,12,12,12,12,12,12,12,12,12,12,12,12,11,11,11,11,11,11,11,11,11,11,10,10,10,10,10,10,9,9,9,8,8,4,0,20,24,24,25,25,25,26,26,26,26,26,26,27,27,27,27,27,27,27,27,27,27,28,28,28,28,28,28,28,28,28,28,28,28,28,28,28,28,28,28,28,29,29,29,29,29,29,29,29,29,29,29,29,29,29,29,29,29,29,29,29,29,29,29},
 {15,15,15,15,15,15,15,15,15,15,15,15,15,15,15,15,15,15,15,15,15,15,15,15,15,15,15,15,15,15,14,14,14,14,14,14,14,14,14,14,14,14,14,14,14,13,13,13,13,13,13,13,13,13,12,12,12,12,12,11,11,10,10,9,0,25,26,26,27,27,28,28,28,28,28,29,29,29,29,29,29,29,29,29,30,30,30,30,30,30,30,30,30,30,30,30,30,30,30,31,31,31,31,31,31,31,31,31,31,31,31,31,31,31,31,31,31,31,31,31,31,31,31,31,31,31,31,31,31}};
__device__ __forceinline__ s16x4 vtr(const LAS unsigned char* p) { return __builtin_bit_cast(s16x4, __builtin_amdgcn_ds_read_tr16_b64_v4i16((LAS s16x4*)p)); }

template <int PASS>
__device__ __forceinline__ void unit_pass(LAS unsigned char* lds, const bf16* Qbh, const bf16* Kbh, const bf16* Vbh, int T0, int wave, int lane_in) {
    constexpr int d = PASS == 0 ? 1 : (PASS == 1 ? 4 : 16), dsh = PASS == 0 ? 0 : (PASS == 1 ? 2 : 4), NBLK = PASS == 2 ? 10 : 5;
    int lane = lane_in; asm volatile("" : "+v"(lane));
    const int r32 = lane & 31, hh = lane >> 5;
    auto qloc = [&](int i) -> int { return PASS == 0 ? 32 * wave + i : (PASS == 1 ? (wave & 3) + 4 * (32 * (wave >> 2) + i) : 2 * wave + (i >> 4) + 16 * (i & 15)); };
    const int tq = T0 + qloc(r32);
    bf16x8 qf[4];
#pragma unroll
    for (int ks = 0; ks < 4; ++ks) qf[ks] = *(const bf16x8*)(Qbh + (size_t)tq * 512 + 16 * ks + 8 * hh);
    const LAS float* bias = (const LAS float*)(lds + A_BIAS) + PASS * 132;
    LAS unsigned char* vst = lds + A_V + wave * 8192;
    const LAS unsigned char* vrd = vst + ((lane >> 4) & 1) * 32 + (lane & 3) * 8 + (4 * hh + ((lane & 15) >> 2)) * 64;
    f32x16 o[2] = {}; float lp = 0.f;
#pragma unroll 1
    for (int blk = 0; blk < NBLK; ++blk) {
        int kbase;
        if (PASS == 0) kbase = T0 + 32 * wave + 32 * (blk - 2);
        else if (PASS == 1) kbase = T0 + (wave & 3) + 4 * (32 * (wave >> 2) + 32 * (blk - 2));
        else kbase = T0 + 2 * wave + (blk >= 5 ? 1 : 0) + 16 * 32 * ((blk >= 5 ? blk - 5 : blk) - 2);
        asm volatile("s_waitcnt lgkmcnt(0)" ::: "memory");
#pragma unroll
        for (int pc = 0; pc < 4; ++pc) { const int d0 = pc >> 1, kg = pc & 1; int kt = kbase + d * (16 * kg + (lane >> 2)); kt = kt < 0 ? 0 : (kt > SEQ - 1 ? SEQ - 1 : kt);
            __builtin_amdgcn_global_load_lds((const unsigned*)(Vbh + (size_t)kt * 512 + 32 * d0 + (lane & 3) * 8), (LAS unsigned*)(vst + pc * 1024), 16, 0, 0); }
        int ktr = kbase + d * r32; ktr = ktr < 0 ? 0 : (ktr > SEQ - 1 ? SEQ - 1 : ktr);
        f32x16 acc = {};
#pragma unroll
        for (int ks = 0; ks < 4; ++ks) acc = mfma32(*(const bf16x8*)(Kbh + (size_t)ktr * 512 + 16 * ks + 8 * hh), qf[ks], acc);
        f32x16 p;
#pragma unroll
        for (int r = 0; r < 16; ++r) {
            const int kt = kbase + d * crow(r, hh), rel = kt - tq;
            const bool ok = (kt >= 0) && (kt < SEQ) && ((rel & (d - 1)) == 0) && (rel >= -64 * d) && (rel <= 64 * d);
            const float bv = bias[ok ? (rel >> dsh) + 64 : 64];
            p[r] = ok ? __expf(acc[r] + bv) : 0.f;
            lp += p[r];
        }
        asm volatile("s_waitcnt vmcnt(0)" ::: "memory");
        __builtin_amdgcn_sched_barrier(0);
#pragma unroll
        for (int s = 0; s < 2; ++s) {
            const bf16x8 pa = pack8(p, 8 * s);
#pragma unroll
            for (int d0 = 0; d0 < 2; ++d0) {
                const s16x4 lo = vtr(vrd + d0 * 2048 + s * 1024), hi = vtr(vrd + d0 * 2048 + s * 1024 + 512);
                const bf16x8 vf = (bf16x8){lo[0], lo[1], lo[2], lo[3], hi[0], hi[1], hi[2], hi[3]};
                o[d0] = mfma32(pa, vf, o[d0]);
            }
        }
    }
    lp += __shfl_xor(lp, 32);
    LAS float* Oacc = (LAS float*)(lds + A_OACC); LAS float* Lacc = (LAS float*)(lds + A_L);
    if (hh == 0) { const int ql = qloc(r32); if (PASS == 0) Lacc[ql] = lp; else Lacc[ql] += lp; }
#pragma unroll
    for (int r = 0; r < 16; ++r) { const int ql = qloc(crow(r, hh));
#pragma unroll
        for (int d0 = 0; d0 < 2; ++d0) { LAS float* dst = Oacc + ql * 64 + 32 * d0 + r32; if (PASS == 0) *dst = o[d0][r]; else *dst += o[d0][r]; } }
    asm volatile("s_waitcnt vmcnt(0) lgkmcnt(0)" ::: "memory"); __syncthreads();
}

__device__ __forceinline__ void unit(LAS unsigned char* lds, const bf16* QB, const bf16* KB, const bf16* VB, const float* rel_bias, bf16* AO, int u, int wave, int lane) {
    const int bh = u >> 5, b = bh >> 3, h = bh & 7, T0 = (u & 31) * 256;
    for (int i = threadIdx.x; i < 387; i += NWAVES * 64) { const int p = i / 129, jj = i - 129 * p; ((LAS float*)(lds + A_BIAS))[p * 132 + jj] = rel_bias[(int)BUCKET[p][jj] * AH + h]; }
    asm volatile("s_waitcnt vmcnt(0) lgkmcnt(0)" ::: "memory"); __syncthreads();
    const size_t hb = (size_t)b * SEQ * 512 + h * 64;
    unit_pass<0>(lds, QB + hb, KB + hb, VB + hb, T0, wave, lane);
    unit_pass<1>(lds, QB + hb, KB + hb, VB + hb, T0, wave, lane);
    unit_pass<2>(lds, QB + hb, KB + hb, VB + hb, T0, wave, lane);
    {
        const int tl = threadIdx.x >> 1, half = threadIdx.x & 1;
        const LAS f32x4* src = (const LAS f32x4*)(lds + A_OACC + (tl * 64 + 32 * half) * 4);
        const float rl = 1.0f / ((const LAS float*)(lds + A_L))[tl];
        bf16* dst = AO + ((size_t)b * SEQ + T0 + tl) * 512 + h * 64 + 32 * half;
#pragma unroll
        for (int q4 = 0; q4 < 4; ++q4) { const f32x4 x0 = src[2 * q4] * rl, x1 = src[2 * q4 + 1] * rl;
            *(u32x4*)(dst + 8 * q4) = (u32x4){gdn::pkbf(x0[0], x0[1]), gdn::pkbf(x0[2], x0[3]), gdn::pkbf(x1[0], x1[1]), gdn::pkbf(x1[2], x1[3])}; }
    }
    asm volatile("s_waitcnt lgkmcnt(0)" ::: "memory"); __syncthreads();
}
}
constexpr int N_PHASES = 11;
__global__ void __launch_bounds__(NWAVES * 64, 2) mk_fwd(Args args) {
    extern __shared__ __attribute__((aligned(16))) unsigned char lds[];
    Frame F;
    F.lds = (LAS unsigned char*)lds; F.MISC = (volatile LAS unsigned*)(F.lds + MISC_OFF);
    F.wave = __builtin_amdgcn_readfirstlane((int)threadIdx.x >> 6);
    F.G = gridDim.x; { const int bx = blockIdx.x; F.vcu = (F.G % 8 == 0) ? (bx % 8) * (F.G / 8) + bx / 8 : bx; }
    unsigned char* ws = args.ws;
    F.ctl = (gu32*)(ws + WS_CTL);
    for (int u = (int)threadIdx.x; u < (LDS_BYTES - LDSCTL_OFF) / 4; u += NWAVES * 64) ((LAS unsigned*)(F.lds + LDSCTL_OFF))[u] = 0u;
    __syncthreads();
    XcdBarrier bar = xcd_barrier_post((unsigned*)(F.ctl + CW_BAR) + args.li * XCD_BAR_WORDS, F.MISC + 8);
    const int lo = args.ph_lo, hi = args.ph_hi;
#define IN(k) (lo <= (k) && (k) < hi)
#ifdef TS_PROBE
    unsigned long long* const tsw = (unsigned long long*)(ws + 212 * 1024);
#define STAMP(k) do { if (blockIdx.x == 0 && threadIdx.x == 0) tsw[k] = __builtin_amdgcn_s_memrealtime(); } while (0)
#else
#define STAMP(k) do {} while (0)
#endif
#define SEAM(k) do { if (IN(k) && IN((k) + 1)) xcd_barrier(bar); STAMP((k) + 1); } while (0)
    STAMP(0);
    bf16* XB = (bf16*)(ws + WS_XB); bf16* XB2 = (bf16*)(ws + WS_XB2); bf16* ACT = (bf16*)(ws + WS_ACT);
    float* SS1 = (float*)(ws + WS_SS1); float* SS2 = (float*)(ws + WS_SS2); float* SS3 = (float*)(ws + WS_SS3); float* SS4 = (float*)(ws + WS_SS4);
    const int gw = F.vcu * NWAVES + F.wave, NGW = F.G * NWAVES;

    if (IN(0)) {
        LAS float* scr = (LAS float*)(F.lds + RING_OFF + F.wave * 16384);
        constexpr int NITEMS = I_GU + I_D + I_IN + I_OUT;
        for (int it = gw; it < NITEMS; it += NGW) p0_weight_item(args, 0, it, scr, (int)(threadIdx.x & 63));
        if (blockIdx.x == 0 && (int)threadIdx.x < 192) { float* nwt = (float*)(ws + WS_NWT); nwt[(int)threadIdx.x] = (int)threadIdx.x < 64 ? args.in[IN_QNORM][(int)threadIdx.x] * 0.125f : ((int)threadIdx.x < 128 ? args.in[IN_KNORM][(int)threadIdx.x - 64] : 1.0f); }
        for (int m = gw; m < M; m += NGW) x_row_to_bf16(args.in[IN_X] + (size_t)m * D, XB + (size_t)m * D, SS1 + m, (int)(threadIdx.x & 63));
    }
    SEAM(0);
    if (IN(1)) {
        pg8::Gemm g{XB, (const bf16*)(ws + WS_WGU1), M, NGU, D}; pg8::StaticOrder S; S.init(M, NGU, F.G, (int)blockIdx.x);
        pg8::EpiSwiGLU E{ACT, FF, SS1};
        pg8::gemm_phase<pg8::EpiSwiGLU, pg8::StaticOrder, true, true>(F.lds + RING_OFF, g, S, E);
    }
    SEAM(1);
    if (IN(2)) {
        pg8::Gemm g{ACT, (const bf16*)(ws + WS_WD1), M, D, FF}; pg8::StaticOrder S; S.init(M, D, F.G, (int)blockIdx.x);
        pg8::EpiResid E{args.in[IN_X], args.out, XB, SS2, 0.5f};
        pg8::gemm_phase<pg8::EpiResid, pg8::StaticOrder, true, true>(F.lds + RING_OFF, g, S, E);
    }
    SEAM(2);
    if (IN(3)) {
        pg8::Gemm g{XB, (const bf16*)(ws + WS_WIN), M, NIN_PAD, D}; pg8::StaticOrder S; S.init(M, NIN_PAD, F.G, (int)blockIdx.x);
        pg8::EpiProj E{(bf16*)(ws + WS_QKVA), (bf16*)(ws + WS_QB), (float*)(ws + WS_AB), SS2, (const float*)(ws + WS_NWT)};
        pg8::gemm_phase<pg8::EpiProj, pg8::StaticOrder, true, true>(F.lds + RING_OFF, g, S, E);
    }
    SEAM(3);
    const gdn::Bufs GB{(const bf16*)(ws + WS_QKVA), (const float*)(ws + WS_AB), (bf16*)(ws + WS_QF), (bf16*)(ws + WS_KT), (bf16*)(ws + WS_WF), (bf16*)(ws + WS_IF), (bf16*)(ws + WS_UC), (float*)(ws + WS_SCAL), (unsigned*)(ws + 208 * 1024)};
    if (IN(4)) {
        for (int it = blockIdx.x; it < 8 * 128; it += F.G) gdn::prep_item(F.lds + RING_OFF, GB, args.in[IN_CONVW], args.in[IN_ALOG], args.in[IN_DTBIAS], it >> 7, it & 127, F.wave, (int)(threadIdx.x & 63));
    }
    SEAM(4);
    if (IN(5)) {
        constexpr int NSCAN = 64;
        if (blockIdx.x < NSCAN) gdn::scan_wg(F.lds + RING_OFF, GB, (int)blockIdx.x >> 2, (int)blockIdx.x & 3, F.wave, (int)(threadIdx.x & 63));
        else for (int u = (int)blockIdx.x - NSCAN; u < 512; u += F.G - NSCAN)
            attn::unit(F.lds + RING_OFF, (const bf16*)(ws + WS_QB), (const bf16*)(ws + WS_KB), (const bf16*)(ws + WS_VB), args.in[IN_RELBIAS], (bf16*)(ws + WS_AO), u, F.wave, (int)(threadIdx.x & 63));
    }
    SEAM(5);
    if (IN(6)) {
        for (int it = gw; it < 8 * 128 * 2; it += NGW) gdn::finalize_item(GB, (const bf16*)(ws + WS_Z), args.in[IN_GDN_NORM], XB, it, (int)(threadIdx.x & 63));
        for (int m = gw; m < M; m += NGW) *(GAS v4u*)(XB + (size_t)m * D + 512 + (threadIdx.x & 63) * 8) = *(const GAS v4u*)((const bf16*)(ws + WS_AO) + (size_t)m * 512 + (threadIdx.x & 63) * 8);
        LAS float* scr = (LAS float*)(F.lds + RING_OFF + F.wave * 16384);
        for (int it = gw; it < I_GU + I_D; it += NGW) p0_weight_item(args, 1, it, scr, (int)(threadIdx.x & 63));
    }
    SEAM(6);
    if (IN(7)) {
        pg8::Gemm g{XB, (const bf16*)(ws + WS_WOUT), M, D, D}; pg8::StaticOrder S; S.init(M, D, F.G, (int)blockIdx.x);
        pg8::EpiResid E{args.out, args.out, XB2, SS3, 1.0f};
        pg8::gemm_phase<pg8::EpiResid, pg8::StaticOrder, true, true>(F.lds + RING_OFF, g, S, E);
    }
    SEAM(7);
    if (IN(8)) {
        pg8::Gemm g{XB2, (const bf16*)(ws + WS_WGU2), M, NGU, D}; pg8::StaticOrder S; S.init(M, NGU, F.G, (int)blockIdx.x);
        pg8::EpiSwiGLU E{ACT, FF, SS3};
        pg8::gemm_phase<pg8::EpiSwiGLU, pg8::StaticOrder, true, true>(F.lds + RING_OFF, g, S, E);
    }
    SEAM(8);
    if (IN(9)) {
        pg8::Gemm g{ACT, (const bf16*)(ws + WS_WD2), M, D, FF}; pg8::StaticOrder S; S.init(M, D, F.G, (int)blockIdx.x);
        pg8::EpiResid E{args.out, args.out, nullptr, SS4, 0.5f};
        pg8::gemm_phase<pg8::EpiResid, pg8::StaticOrder, true, true>(F.lds + RING_OFF, g, S, E);
    }
    SEAM(9);
    if (IN(10)) {
        for (int m = gw; m < M; m += NGW) final_norm_row(args.out + (size_t)m * D, args.in[IN_FINAL_NORM], SS4[m], (int)(threadIdx.x & 63));
    }
#ifdef TS_PROBE
    xcd_barrier(bar); STAMP(11);
    asm volatile("s_waitcnt vmcnt(0)" ::: "memory"); __syncthreads();
    { const float dl = (float)(tsw[TSEL + 1] - tsw[TSEL]) * 0.01f * (1.0f / TS_SCALE);
      for (size_t i = (size_t)blockIdx.x * 512 + threadIdx.x; i < ((size_t)1 << 20); i += (size_t)gridDim.x * 512) args.out[1 + i] += dl; }
#endif
#undef IN
#undef SEAM
}

namespace ref {
constexpr int CONVW = 5;
__device__ const unsigned char BUCKET[3][129] = {
 {11,11,11,11,11,11,11,11,11,11,11,11,11,11,11,10,10,10,10,10,10,10,10,10,10,10,10,10,10,10,10,10,10,10,10,10,10,10,9,9,9,9,9,9,9,9,9,9,9,9,8,8,8,8,8,8,8,7,6,5,4,3,2,1,0,17,18,19,20,21,22,23,24,24,24,24,24,24,24,25,25,25,25,25,25,25,25,25,25,25,25,26,26,26,26,26,26,26,26,26,26,26,26,26,26,26,26,26,26,26,26,26,26,26,27,27,27,27,27,27,27,27,27,27,27,27,27,27,27},
 {13,13,13,13,13,13,13,13,13,13,13,13,13,13,13,13,13,13,13,13,13,13,13,12,12,12,12,12,12,12,12,12,12,12,12,12,12,12,12,12,12,12,11,11,11,11,11,11,11,11,11,11,10,10,10,10,10,10,9,9,9,8,8,4,0,20,24,24,25,25,25,26,26,26,26,26,26,27,27,27,27,27,27,27,27,27,27,28,28,28,28,28,28,28,28,28,28,28,28,28,28,28,28,28,28,28,29,29,29,29,29,29,29,29,29,29,29,29,29,29,29,29,29,29,29,29,29,29,29},
 {15,15,15,15,15,15,15,15,15,15,15,15,15,15,15,15,15,15,15,15,15,15,15,15,15,15,15,15,15,15,14,14,14,14,14,14,14,14,14,14,14,14,14,14,14,13,13,13,13,13,13,13,13,13,12,12,12,12,12,11,11,10,10,9,0,25,26,26,27,27,28,28,28,28,28,29,29,29,29,29,29,29,29,29,30,30,30,30,30,30,30,30,30,30,30,30,30,30,30,31,31,31,31,31,31,31,31,31,31,31,31,31,31,31,31,31,31,31,31,31,31,31,31,31,31,31,31,31,31}};
__device__ __forceinline__ float wave_max(float v) {
#pragma unroll
    for (int o = 1; o < 64; o <<= 1) v = fmaxf(v, __shfl_xor(v, o));
    return v;
}
__device__ __forceinline__ float silu(float x) { return x / (1.f + __expf(-x)); }
__global__ void __launch_bounds__(256) gdn_pre_k(const bf16* __restrict__ qkva, const float* __restrict__ ab, const float* __restrict__ conv_w, const float* __restrict__ a_log, const float* __restrict__ dt_bias,
                                                 bf16* __restrict__ qkvc, float* __restrict__ gbuf, float* __restrict__ bbuf) {
    __shared__ float sums[12];
    const int t = blockIdx.x, tid = threadIdx.x;
    if (tid < 12) sums[tid] = 0.f;
    __syncthreads();
    float val[6];
#pragma unroll
    for (int i = 0; i < 6; ++i) {
        const int c = tid + 256 * i;
        float s = 0.f;
#pragma unroll
        for (int j = 0; j < CONVW; ++j) { const int tt = t + j - 2; if (tt >= 0 && tt < SEQ) s += bf2f(qkva[(size_t)tt * 1536 + c]) * conv_w[c * CONVW + j]; }
        val[i] = silu(s);
        if (c < 1024) atomicAdd(&sums[c >> 7], val[i] * val[i]);
    }
    __syncthreads();
#pragma unroll
    for (int i = 0; i < 6; ++i) {
        const int c = tid + 256 * i;
        float v = val[i];
        if (c < 1024) v *= rsqrtf(sums[c >> 7] + EPS);
        qkvc[(size_t)t * 1536 + c] = (bf16)f2bf(v);
    }
    if (tid < 8) {
        const float a = ab[(size_t)t * 16 + tid] + dt_bias[tid];
        const float sp = (a > 20.f) ? a : log1pf(expf(a));
        gbuf[(size_t)tid * SEQ + t] = -expf(a_log[tid]) * sp;
        const float b = ab[(size_t)t * 16 + 8 + tid];
        bbuf[(size_t)tid * SEQ + t] = 1.f / (1.f + expf(-b));
    }
}
__global__ void __launch_bounds__(1024) gdn_rec_k(const bf16* __restrict__ qkvc, const float* __restrict__ gbuf, const float* __restrict__ bbuf, float* __restrict__ o2) {
    const int dir = blockIdx.x >> 2, h = blockIdx.x & 3, tid = threadIdx.x, dv = tid >> 3, seg = tid & 7;
    float R[16];
#pragma unroll
    for (int i = 0; i < 16; ++i) R[i] = 0.f;
    const float* gp = gbuf + (size_t)(dir * 4 + h) * SEQ; const float* bp = bbuf + (size_t)(dir * 4 + h) * SEQ;
    float* op = o2 + (size_t)dir * SEQ * GW;
    const float qs = 0.08838834764831845f;
    for (int s = 0; s < SEQ; ++s) {
        const int t = dir ? (SEQ - 1 - s) : s;
        const bf16* row = qkvc + (size_t)t * 1536;
        float k[16], q[16];
#pragma unroll
        for (int i = 0; i < 16; ++i) { k[i] = bf2f(row[512 + h * 128 + seg * 16 + i]); q[i] = bf2f(row[h * 128 + seg * 16 + i]); }
        const float v = bf2f(row[1024 + h * 128 + dv]);
        const float eg = expf(gp[t]), beta = bp[t];
        float p = 0.f;
#pragma unroll
        for (int i = 0; i < 16; ++i) p += R[i] * k[i];
        p += __shfl_xor(p, 1); p += __shfl_xor(p, 2); p += __shfl_xor(p, 4);
        const float delta = beta * (v - eg * p);
        float o = 0.f;
#pragma unroll
        for (int i = 0; i < 16; ++i) { R[i] = eg * R[i] + delta * k[i]; o += R[i] * q[i]; }
        o += __shfl_xor(o, 1); o += __shfl_xor(o, 2); o += __shfl_xor(o, 4);
        if (seg == 0) op[(size_t)t * GW + h * 128 + dv] = o * qs;
    }
}
__global__ void __launch_bounds__(512) gdn_post_k(const float* __restrict__ o2, const bf16* __restrict__ z, const float* __restrict__ nw, bf16* __restrict__ mix, int ldm) {
    __shared__ float sums[4];
    const int t = blockIdx.x, c = threadIdx.x;
    if (c < 4) sums[c] = 0.f;
    __syncthreads();
    const float o = o2[(size_t)t * GW + c] + o2[(size_t)SEQ * GW + (size_t)t * GW + c];
    atomicAdd(&sums[c >> 7], o * o);
    __syncthreads();
    mix[(size_t)t * ldm + c] = (bf16)f2bf(o * rsqrtf(sums[c >> 7] * (1.f / 128.f) + EPS) * nw[c & 127] * silu(bf2f(z[(size_t)t * 512 + c])));
}
__global__ void __launch_bounds__(256) attn_k(const bf16* __restrict__ qb, const bf16* __restrict__ kb, const bf16* __restrict__ vb, const float* __restrict__ rel_bias, bf16* __restrict__ mix) {
    const int gw = blockIdx.x * 4 + (threadIdx.x >> 6), lane = threadIdx.x & 63;
    const int t = gw >> 3, h = gw & 7;
    const float qv = bf2f(qb[(size_t)t * 512 + h * 64 + lane]);
    float qa[64];
#pragma unroll
    for (int dd = 0; dd < 64; ++dd) qa[dd] = __shfl(qv, dd);
    float sc[7]; int pos[7];
    float mx = -1e30f;
#pragma unroll
    for (int r = 0; r < 7; ++r) {
        const int e = lane + 64 * r;
        float s = -1e30f; int kp = -1;
        if (e < 387) {
            const int p = e / 129, j = e % 129 - 64, d = (p == 0) ? 1 : (p == 1 ? 4 : 16);
            kp = t + d * j;
            if (kp >= 0 && kp < SEQ) {
                const bf16* kr = kb + (size_t)kp * 512 + h * 64;
                float a = 0.f;
#pragma unroll
                for (int dd = 0; dd < 64; ++dd) a += qa[dd] * bf2f(kr[dd]);
                s = a + rel_bias[(int)BUCKET[p][j + 64] * AH + h];
            } else kp = -1;
        }
        sc[r] = s; pos[r] = kp; mx = fmaxf(mx, s);
    }
    mx = wave_max(mx);
    float l = 0.f;
#pragma unroll
    for (int r = 0; r < 7; ++r) { sc[r] = (pos[r] >= 0) ? __expf(sc[r] - mx) : 0.f; l += sc[r]; }
    l = wave_sum(l);
    float o = 0.f;
#pragma unroll
    for (int r = 0; r < 7; ++r) {
        for (int src = 0; src < 64; ++src) {
            const float pe = __shfl(sc[r], src); const int kp = __shfl(pos[r], src);
            if (kp >= 0) o += pe * bf2f(vb[(size_t)kp * 512 + h * 64 + lane]);
        }
    }
    mix[(size_t)t * D + 512 + h * 64 + lane] = (bf16)f2bf(o / l);
}
__global__ void __launch_bounds__(512) diff_k(bf16* mine, const bf16* refv, unsigned* maxbits) {
    const int t = blockIdx.x, c = threadIdx.x;
    const float a = bf2f(mine[(size_t)t * D + c]), r = bf2f(refv[(size_t)t * 512 + c]);
    float d = fabsf(a - r); if (!(d == d)) d = 7777.f;
    d = wave_max(d);
    if ((c & 63) == 0) atomicMax(maxbits, __float_as_uint(d));
    mine[(size_t)t * D + c] = refv[(size_t)t * 512 + c];
}
__global__ void poke_k(float* out, const unsigned* maxbits) { out[0] = 1000.f * __uint_as_float(*maxbits); }
__global__ void poke_code_k(float* out, const unsigned* code) { out[0] = 1000.f * (float)(*code); }
__global__ void __launch_bounds__(256) nanpos_bf16_k(const bf16* p, size_t n, unsigned* w) {
    unsigned cnt = 0, best = 0;
    for (size_t i = (size_t)blockIdx.x * 256 + threadIdx.x; i < n; i += (size_t)gridDim.x * 256) { if ((p[i] & 0x7f80u) == 0x7f80u) { ++cnt; const unsigned inv = 0xffffffffu - (unsigned)i; best = inv > best ? inv : best; } }
    if (cnt) { atomicAdd(w, cnt); atomicMax(w + 1, best); }
}
__global__ void poke_nanpos_k(float* out, const unsigned* w) {
    const unsigned cnt = w[0]; const unsigned idx = w[1] ? 0xffffffffu - w[1] : 0u;
    int lc = 0; for (unsigned c = cnt; c >= 10; c /= 10) ++lc;
#if NANPOS_MODE == 0
    const unsigned code = (lc > 9 ? 9 : lc) * 10 + ((idx >> 13) & 127) / 16;
#elif NANPOS_MODE == 1
    const unsigned code = ((idx >> 10) & 7) * 10 + ((idx & 15) >> 1);
#else
    const unsigned code = ((idx >> 4) & 63);
#endif
    out[0] = 1000.f * (float)code;
}
__global__ void poke_cat3_k(float* out, const unsigned* mx) {
    unsigned code = 0;
    for (int k = 2; k >= 0; --k) { const float v = __uint_as_float(mx[k]); int cat = (v != v) ? 3 : (v < 2.f ? 0 : (v < 1e4f ? 1 : 2)); code = code * 4 + cat; }
    out[0] = 1000.f * (float)code;
}
__global__ void poke_cat_k(float* out, const unsigned* mx) {
    unsigned code = 0;
    for (int k = 1; k >= 0; --k) { const float v = __uint_as_float(mx[k]); int cat = (v != v) ? 5 : (v < 10.f ? 0 : (v < 100.f ? 1 : (v < 1e4f ? 2 : (v < 1e10f ? 3 : 4)))); code = code * 6 + cat; }
    out[0] = 1000.f * (float)code;
}
__global__ void __launch_bounds__(256) maxabs_bf16_k(const bf16* p, size_t n, unsigned* mx) {
    unsigned best = 0;
    for (size_t i = (size_t)blockIdx.x * 256 + threadIdx.x; i < n; i += (size_t)gridDim.x * 256) { const unsigned b = ((unsigned)p[i] << 16) & 0x7fffffffu; best = b > best ? b : best; }
    atomicMax(mx, best);
}
__global__ void __launch_bounds__(256) chk_bf16_k(const bf16* p, size_t n, unsigned* code, unsigned bit) {
    bool bad = false;
    for (size_t i = (size_t)blockIdx.x * 256 + threadIdx.x; i < n; i += (size_t)gridDim.x * 256) { const float v = bf2f(p[i]); if (!(fabsf(v) < 1e4f)) bad = true; }
    if (__any(bad) && (threadIdx.x & 63) == 0) atomicOr(code, bit);
}
__global__ void __launch_bounds__(256) chk_f32_k(const float* p, size_t n, unsigned* code, unsigned bit) {
    bool bad = false;
    for (size_t i = (size_t)blockIdx.x * 256 + threadIdx.x; i < n; i += (size_t)gridDim.x * 256) { const float v = p[i]; if (!(fabsf(v) < 1e4f)) bad = true; }
    if (__any(bad) && (threadIdx.x & 63) == 0) atomicOr(code, bit);
}
}

extern "C" void kernel_launch(void* const* d_in, const int* in_sizes, int n_in, void* d_out, int out_size, void* d_ws, size_t ws_size, hipStream_t stream) {
    static int grid = 0;
    if (grid == 0) {
        if (n_in != 20 || in_sizes[0] != M * D || out_size != M * D || ws_size < WS_END) { fprintf(stderr, "kernel_launch: unexpected shapes (n_in %d, in0 %d, out %d, ws %zu)\n", n_in, n_in > 0 ? in_sizes[0] : -1, out_size, ws_size); grid = -1; return; }
        int dev = 0, cus = 0, per_cu = 0;
        if (hipGetDevice(&dev) != hipSuccess || hipDeviceGetAttribute(&cus, hipDeviceAttributeMultiprocessorCount, dev) != hipSuccess) { grid = -1; return; }
        if (hipFuncSetAttribute((const void*)mk_fwd, hipFuncAttributeMaxDynamicSharedMemorySize, LDS_BYTES) != hipSuccess) { fprintf(stderr, "kernel_launch: hipFuncSetAttribute failed\n"); grid = -1; return; }
        if (hipOccupancyMaxActiveBlocksPerMultiprocessor(&per_cu, (const void*)mk_fwd, NWAVES * 64, LDS_BYTES) != hipSuccess || per_cu < 1) { fprintf(stderr, "kernel_launch: occupancy query reports %d\n", per_cu); per_cu = 1; }
        (void)hipGetLastError();
        grid = cus;
    }
    if (grid < 0) return;
    unsigned char* ws = (unsigned char*)d_ws;
    (void)hipMemsetAsync(ws + WS_CTL, 0, CTL_ZERO_BYTES, stream);
    Args a{};
    for (int i = 0; i < 20; ++i) a.in[i] = (const float*)d_in[i];
    a.out = (float*)d_out; a.ws = ws;
    a.ph_lo = 0; a.ph_hi = N_PHASES; a.li = 0;
    hipLaunchKernelGGL(mk_fwd, dim3(grid), dim3(NWAVES * 64), LDS_BYTES, stream, a);
}
```

```cpp
#include <hip/hip_runtime.h>
#include <cstdio>
#include <cstdint>
namespace pg8 {
#define PG8_LAS __attribute__((address_space(3)))
typedef unsigned short bf16_t;
typedef short bf16x8 __attribute__((ext_vector_type(8)));
typedef float f32x4 __attribute__((ext_vector_type(4)));
typedef unsigned u32x4 __attribute__((ext_vector_type(4)));
constexpr int BM = 256, BK = 64, HALF = 128, HTB = HALF * BK * 2  , STAGE_BYTES = 8 * HTB, NXCD = 8, WGM = 8;

__host__ __device__ __forceinline__ int lds_byte(int r, int c) { const int st = (r >> 4) * 2 + (c >> 5), rr = r & 15, cc = c & 31, ob = rr * 64 + cc * 2; return st * 1024 + (ob ^ (((ob >> 9) & 1) << 5)); }
__host__ __device__ __forceinline__ void stage_rc(int b, int& R, int& C) { const int st = b / 1024, sb = b % 1024, swz = sb ^ (((sb >> 9) & 1) << 5); R = (st >> 1) * 16 + swz / 64; C = (st & 1) * 32 + (swz % 64) / 2; }
__host__ __device__ __forceinline__ int perm32(int rho) { const int n = rho >> 4, i = rho & 15; return 8 * (i >> 2) + 4 * n + (i & 3); }

struct Unit { int pm, pn; };
struct Gemm { const bf16_t* A; const bf16_t* Bt; int M, N, K; };

struct StaticOrder {
    int nM, nN, nwg, G, c;
    __host__ __device__ void init(int M, int N, int G_, int c_) { nM = M / BM; nN = N / BM; nwg = nM * nN; G = G_; c = c_; }
    __host__ __device__ bool next(int i, Unit& u) const {
        const long L = (long)i * G + c; if (L >= nwg) return false;
        int wgid = (int)L; { const int q = nwg / NXCD, r = nwg % NXCD, xcd = wgid % NXCD, off = wgid / NXCD; wgid = (xcd < r ? xcd * (q + 1) : r * (q + 1) + (xcd - r) * q) + off; }
        const int nig = WGM * nN, gid = wgid / nig, fm = gid * WGM, gsz = (nM - fm) < WGM ? (nM - fm) : WGM;
        u.pm = fm + ((wgid % nig) % gsz); u.pn = (wgid % nig) / gsz; return true;
    }
    __device__ __forceinline__ void a_ready(const Unit&) const {}
    __device__ __forceinline__ void done(const Unit&) const {}
};

__device__ __forceinline__ unsigned cvt_pk_bf16(float lo, float hi) { unsigned r; asm volatile("v_cvt_pk_bf16_f32 %0, %1, %2" : "=v"(r) : "v"(lo), "v"(hi)); return r; }
__device__ __forceinline__ float fast_silu(float x) { return x * __builtin_amdgcn_rcpf(1.0f + __builtin_amdgcn_exp2f(-1.4426950408889634f * x)); }
constexpr float RMS_EPS = 1e-6f;

struct EpiSwiGLU {
    static constexpr bool PERM = true, AFTER_DRAIN = false;
    bf16_t* O; int ldc; const float* ss;
    __device__ __forceinline__ void operator()(const f32x4 (&acc)[2][2][4][2], const Unit& u, int wr, int wc, int fr, int fq) const {
        const int row0 = u.pm * BM + wr * 64 + fr, col0 = u.pn * HALF + wc * 32 + 8 * fq;
#pragma unroll
        for (int ai = 0; ai < 2; ++ai)
#pragma unroll
            for (int m = 0; m < 4; ++m) {
                const int row = row0 + ai * HALF + m * 16;
                const float r = rsqrtf(ss[row] * (1.0f / 1024.0f) + RMS_EPS);
                const f32x4 g0 = acc[ai][0][m][0] * r, g1 = acc[ai][0][m][1] * r, u0 = acc[ai][1][m][0] * r, u1 = acc[ai][1][m][1] * r;
                u32x4 w;
                w.x = cvt_pk_bf16(fast_silu(g0[0]) * u0[0], fast_silu(g0[1]) * u0[1]); w.y = cvt_pk_bf16(fast_silu(g0[2]) * u0[2], fast_silu(g0[3]) * u0[3]);
                w.z = cvt_pk_bf16(fast_silu(g1[0]) * u1[0], fast_silu(g1[1]) * u1[1]); w.w = cvt_pk_bf16(fast_silu(g1[2]) * u1[2], fast_silu(g1[3]) * u1[3]);
                *(u32x4*)(O + (size_t)row * ldc + col0) = w;
            }
    }
};
struct EpiResid {
    static constexpr bool PERM = true, AFTER_DRAIN = false;
    const float* base; float* out; bf16_t* xb; float* ss_out; float alpha;
    __device__ __forceinline__ void operator()(const f32x4 (&acc)[2][2][4][2], const Unit& u, int wr, int wc, int fr, int fq) const {
        const int row0 = u.pm * BM + wr * 64 + fr, col0 = u.pn * BM + wc * 32 + 8 * fq;
#pragma unroll
        for (int ai = 0; ai < 2; ++ai)
#pragma unroll
            for (int m = 0; m < 4; ++m) {
                const int row = row0 + ai * HALF + m * 16; float s = 0.f;
#pragma unroll
                for (int bj = 0; bj < 2; ++bj) {
                    const size_t off = (size_t)row * 1024 + col0 + bj * HALF;
                    const f32x4 b0 = *(const f32x4*)(base + off), b1 = *(const f32x4*)(base + off + 4);
                    const f32x4 v0 = b0 + acc[ai][bj][m][0] * alpha, v1 = b1 + acc[ai][bj][m][1] * alpha;
                    *(f32x4*)(out + off) = v0; *(f32x4*)(out + off + 4) = v1;
                    if (xb) { u32x4 w; w.x = cvt_pk_bf16(v0[0], v0[1]); w.y = cvt_pk_bf16(v0[2], v0[3]); w.z = cvt_pk_bf16(v1[0], v1[1]); w.w = cvt_pk_bf16(v1[2], v1[3]); *(u32x4*)(xb + off) = w; }
                    s += (v0[0] * v0[0] + v0[1] * v0[1]) + (v0[2] * v0[2] + v0[3] * v0[3]) + (v1[0] * v1[0] + v1[1] * v1[1]) + (v1[2] * v1[2] + v1[3] * v1[3]);
                }
                if (ss_out) { s += __shfl_xor(s, 16); s += __shfl_xor(s, 32); if (fq == 0) atomicAdd(ss_out + row, s); }
            }
    }
};
struct EpiProj {
    static constexpr bool PERM = true, AFTER_DRAIN = false;
    bf16_t* qkva; bf16_t* qkvb; float* ab; const float* ss; const float* nwt;
    static constexpr size_t Z_OFF = (size_t)16384 * 1536, QKVB_STRIDE = (size_t)16384 * 512;
    __device__ __forceinline__ void operator()(const f32x4 (&acc)[2][2][4][2], const Unit& u, int wr, int wc, int fr, int fq) const {
        const int row0 = u.pm * BM + wr * 64 + fr, pn = u.pn;
        if (pn < 8) {
            bf16_t* dst = qkva + (pn < 6 ? (size_t)0 : Z_OFF); const int ld = pn < 6 ? 1536 : 512; const int col0 = (pn < 6 ? pn : pn - 6) * BM + wc * 32 + 8 * fq;
#pragma unroll
            for (int ai = 0; ai < 2; ++ai)
#pragma unroll
                for (int m = 0; m < 4; ++m) { const int row = row0 + ai * HALF + m * 16; const float r = rsqrtf(ss[row] * (1.0f / 1024.0f) + RMS_EPS);
#pragma unroll
                    for (int bj = 0; bj < 2; ++bj) { const f32x4 v0 = acc[ai][bj][m][0] * r, v1 = acc[ai][bj][m][1] * r;
                        u32x4 w; w.x = cvt_pk_bf16(v0[0], v0[1]); w.y = cvt_pk_bf16(v0[2], v0[3]); w.z = cvt_pk_bf16(v1[0], v1[1]); w.w = cvt_pk_bf16(v1[2], v1[3]);
                        *(u32x4*)(dst + (size_t)row * ld + col0 + bj * HALF) = w; } }
        } else if (pn < 14) {
            const int sec = (pn - 8) >> 1, head = 4 * ((pn - 8) & 1) + wc;
            bf16_t* dst = qkvb + (size_t)sec * QKVB_STRIDE;
            const float* nw = nwt + sec * 64;
            f32x4 wv[2][2];
#pragma unroll
            for (int bj = 0; bj < 2; ++bj)
#pragma unroll
                for (int n = 0; n < 2; ++n) wv[bj][n] = *(const f32x4*)(nw + 32 * bj + 8 * fq + 4 * n);
#pragma unroll
            for (int ai = 0; ai < 2; ++ai)
#pragma unroll
                for (int m = 0; m < 4; ++m) { const int row = row0 + ai * HALF + m * 16; const float r = rsqrtf(ss[row] * (1.0f / 1024.0f) + RMS_EPS);
                    f32x4 v[2][2]; float s = 0.f;
#pragma unroll
                    for (int bj = 0; bj < 2; ++bj)
#pragma unroll
                        for (int n = 0; n < 2; ++n) { v[bj][n] = acc[ai][bj][m][n] * r; s += (v[bj][n][0] * v[bj][n][0] + v[bj][n][1] * v[bj][n][1]) + (v[bj][n][2] * v[bj][n][2] + v[bj][n][3] * v[bj][n][3]); }
                    s += __shfl_xor(s, 16); s += __shfl_xor(s, 32);
                    const float rn = sec < 2 ? rsqrtf(s * (1.0f / 64.0f) + RMS_EPS) : 1.0f;
#pragma unroll
                    for (int bj = 0; bj < 2; ++bj) { const f32x4 v0 = v[bj][0] * wv[bj][0] * rn, v1 = v[bj][1] * wv[bj][1] * rn;
                        u32x4 w; w.x = cvt_pk_bf16(v0[0], v0[1]); w.y = cvt_pk_bf16(v0[2], v0[3]); w.z = cvt_pk_bf16(v1[0], v1[1]); w.w = cvt_pk_bf16(v1[2], v1[3]);
                        *(u32x4*)(dst + (size_t)row * 512 + head * 64 + 32 * bj + 8 * fq) = w; } }
        } else {
            if (wc == 0 && fq < 2) {
#pragma unroll
                for (int ai = 0; ai < 2; ++ai)
#pragma unroll
                    for (int m = 0; m < 4; ++m) { const int row = row0 + ai * HALF + m * 16; const float r = rsqrtf(ss[row] * (1.0f / 1024.0f) + RMS_EPS);
                        *(f32x4*)(ab + (size_t)row * 16 + 8 * fq) = acc[ai][0][m][0] * r; *(f32x4*)(ab + (size_t)row * 16 + 8 * fq + 4) = acc[ai][0][m][1] * r; }
            }
        }
    }
};

template <class Epi, class Sched, bool ALIGN_EPI = false, bool SP2 = false>
__device__ __forceinline__ void gemm_phase(PG8_LAS unsigned char* lds, const Gemm g, const Sched& S, const Epi& E) {
    const int tid = threadIdx.x, wid = __builtin_amdgcn_readfirstlane(tid >> 6), lane = tid & 63, wr = wid >> 2, wc = wid & 3, fr = lane & 15, fq = lane >> 4;
    const int K = g.K, nt = K / BK;
    unsigned voffA[2], voffB[2];
#pragma unroll
    for (int i = 0; i < 2; ++i) { int R, C; stage_rc(tid * 16 + i * 8192, R, C); const int Rb = Epi::PERM ? ((R & ~31) + perm32(R & 31)) : R;
        voffA[i] = (unsigned)(R * K + C) * 2u; voffB[i] = (unsigned)(Rb * K + C) * 2u; }
    const size_t kstep = (size_t)(BK * 2);
    const size_t hstep = (size_t)HALF * K * 2;
    const size_t tstep = 2 * hstep;
    const unsigned ldsw = (unsigned)wid * 1024u;
    const int aoff = lds_byte(wr * 64 + fr, fq * 8), boff = lds_byte(wc * 32 + fr, fq * 8);
#define PG8_SA(b, h) (((b) * 2 + (h)) * HTB)
#define PG8_SB(b, h) ((4 + (b) * 2 + (h)) * HTB)
#define PG8_STAGE(bufoff, gbase, voff) do { _Pragma("unroll") for (int _i = 0; _i < 2; ++_i) \
        __builtin_amdgcn_global_load_lds((const unsigned*)((const char*)(gbase) + (voff)[_i]), (PG8_LAS unsigned*)(lds + (bufoff) + ldsw + _i * 8192), 16, 0, 0); } while (0)
#define PG8_LDA(dst, b, h) do { _Pragma("unroll") for (int m = 0; m < 4; ++m) _Pragma("unroll") for (int k = 0; k < 2; ++k) dst[m][k] = *(const PG8_LAS bf16x8*)(lds + PG8_SA(b, h) + aoff + m * 2048 + k * 1024); } while (0)
#define PG8_LDB(dst, b, h) do { _Pragma("unroll") for (int n = 0; n < 2; ++n) _Pragma("unroll") for (int k = 0; k < 2; ++k) dst[n][k] = *(const PG8_LAS bf16x8*)(lds + PG8_SB(b, h) + boff + n * 2048 + k * 1024); } while (0)
#define PG8_MMA(ai, bj, At, Bt) do { __builtin_amdgcn_s_setprio(1); _Pragma("unroll") for (int m = 0; m < 4; ++m) _Pragma("unroll") for (int n = 0; n < 2; ++n) _Pragma("unroll") for (int k = 0; k < 2; ++k) \
        acc[ai][bj][m][n] = __builtin_amdgcn_mfma_f32_16x16x32_bf16(Bt[n][k], At[m][k], acc[ai][bj][m][n], 0, 0, 0); __builtin_amdgcn_s_setprio(0); } while (0)
#define PG8_WAIT_V(n) asm volatile("s_waitcnt vmcnt(" #n ")" ::: "memory")
#define PG8_WAIT_L(n) asm volatile("s_waitcnt lgkmcnt(" #n ")" ::: "memory")
#define PG8_BAR __builtin_amdgcn_s_barrier()
#define PG8_SCHED __builtin_amdgcn_sched_barrier(0)
    Unit cur, nxt; int ui = 0;
    if (!S.next(0, cur)) return;
    f32x4 acc[2][2][4][2];
#pragma unroll
    for (int a = 0; a < 2; ++a)
#pragma unroll
        for (int b = 0; b < 2; ++b)
#pragma unroll
            for (int m = 0; m < 4; ++m)
#pragma unroll
                for (int n = 0; n < 2; ++n) acc[a][b][m][n] = (f32x4){0.f, 0.f, 0.f, 0.f};
    bf16x8 At[4][2], B0[2][2], B1[2][2];
    const char* cA = (const char*)g.A + (size_t)cur.pm * tstep; const char* cB = (const char*)g.Bt + (size_t)cur.pn * tstep;
    S.a_ready(cur);
    if constexpr (SP2) {
        PG8_STAGE(PG8_SB(0, 0), cB, voffB); PG8_STAGE(PG8_SB(0, 1), cB + hstep, voffB); PG8_STAGE(PG8_SA(0, 0), cA, voffA); PG8_STAGE(PG8_SA(0, 1), cA + hstep, voffA);
        if (wr == 1) PG8_BAR;
        PG8_WAIT_V(2); PG8_BAR;
        PG8_STAGE(PG8_SB(1, 0), cB + kstep, voffB); PG8_STAGE(PG8_SA(1, 0), cA + kstep, voffA); PG8_STAGE(PG8_SB(1, 1), cB + hstep + kstep, voffB);
        PG8_WAIT_V(6); PG8_BAR;
    } else {
        PG8_STAGE(PG8_SB(0, 0), cB, voffB); PG8_STAGE(PG8_SA(0, 0), cA, voffA); PG8_STAGE(PG8_SB(0, 1), cB + hstep, voffB); PG8_STAGE(PG8_SA(0, 1), cA + hstep, voffA);
        if (wr == 1) PG8_BAR;
        PG8_WAIT_V(4); PG8_BAR;
        PG8_STAGE(PG8_SB(1, 0), cB + kstep, voffB); PG8_STAGE(PG8_SA(1, 0), cA + kstep, voffA); PG8_STAGE(PG8_SB(1, 1), cB + hstep + kstep, voffB);
        PG8_WAIT_V(6); PG8_BAR;
    }
    for (;;) {
        const bool has_next = S.next(ui + 1, nxt);
        const char* nA = has_next ? (const char*)g.A + (size_t)nxt.pm * tstep : cA; const char* nB = has_next ? (const char*)g.Bt + (size_t)nxt.pn * tstep : cB;
        for (int t = 0; t < nt; t += 2) {
            const bool last = (t == nt - 2);
            const char* a1 = cA + (size_t)(t + 1) * kstep;
            const char* a2 = last ? nA : cA + (size_t)(t + 2) * kstep; const char* b2 = last ? nB : cB + (size_t)(t + 2) * kstep;
            const char* a3 = a2 + kstep; const char* b3 = b2 + kstep;
            if (last && has_next) S.a_ready(nxt);
            if constexpr (SP2) {
            PG8_LDB(B0, 0, 0); PG8_LDB(B1, 0, 1); PG8_SCHED; PG8_LDA(At, 0, 0); PG8_STAGE(PG8_SA(1, 1), a1 + hstep, voffA);
            PG8_WAIT_V(8); PG8_WAIT_L(0); PG8_BAR; PG8_MMA(0, 0, At, B0); PG8_MMA(0, 1, At, B1); PG8_BAR; PG8_SCHED;
            PG8_LDA(At, 0, 1); PG8_STAGE(PG8_SB(0, 0), b2, voffB); PG8_STAGE(PG8_SB(0, 1), b2 + hstep, voffB); PG8_STAGE(PG8_SA(0, 0), a2, voffA);
            PG8_WAIT_V(8); PG8_WAIT_L(0); PG8_BAR; PG8_MMA(1, 0, At, B0); PG8_MMA(1, 1, At, B1); PG8_BAR; PG8_SCHED;
            PG8_LDB(B0, 1, 0); PG8_LDB(B1, 1, 1); PG8_SCHED; PG8_LDA(At, 1, 0); PG8_STAGE(PG8_SA(0, 1), a2 + hstep, voffA);
            PG8_WAIT_V(8); PG8_WAIT_L(0); PG8_BAR; PG8_MMA(0, 0, At, B0); PG8_MMA(0, 1, At, B1); PG8_BAR; PG8_SCHED;
            PG8_LDA(At, 1, 1); PG8_STAGE(PG8_SB(1, 0), b3, voffB); PG8_STAGE(PG8_SB(1, 1), b3 + hstep, voffB); PG8_STAGE(PG8_SA(1, 0), a3, voffA);
            PG8_WAIT_V(8); PG8_WAIT_L(0); PG8_BAR; PG8_MMA(1, 0, At, B0); PG8_MMA(1, 1, At, B1); PG8_BAR; PG8_SCHED;
            } else {
            PG8_LDB(B0, 0, 0); PG8_SCHED; PG8_LDA(At, 0, 0); PG8_STAGE(PG8_SA(1, 1), a1 + hstep, voffA);
            PG8_WAIT_L(8); PG8_BAR; PG8_WAIT_L(0); PG8_MMA(0, 0, At, B0); PG8_BAR; PG8_SCHED;
            PG8_LDB(B1, 0, 1); PG8_STAGE(PG8_SB(0, 0), b2, voffB);
            PG8_BAR; PG8_WAIT_L(0); PG8_MMA(0, 1, At, B1); PG8_BAR;
            PG8_LDA(At, 0, 1); PG8_STAGE(PG8_SA(0, 0), a2, voffA);
            PG8_BAR; PG8_WAIT_L(0); PG8_MMA(1, 0, At, B0); PG8_BAR; PG8_SCHED;
            PG8_STAGE(PG8_SB(0, 1), b2 + hstep, voffB);
            PG8_WAIT_V(6); PG8_BAR; PG8_MMA(1, 1, At, B1); PG8_BAR;
            PG8_LDB(B0, 1, 0); PG8_SCHED; PG8_LDA(At, 1, 0); PG8_STAGE(PG8_SA(0, 1), a2 + hstep, voffA);
            PG8_WAIT_L(8); PG8_BAR; PG8_WAIT_L(0); PG8_MMA(0, 0, At, B0); PG8_BAR; PG8_SCHED;
            PG8_LDB(B1, 1, 1); PG8_STAGE(PG8_SB(1, 0), b3, voffB);
            PG8_BAR; PG8_WAIT_L(0); PG8_MMA(0, 1, At, B1); PG8_BAR;
            PG8_LDA(At, 1, 1); PG8_STAGE(PG8_SA(1, 0), a3, voffA);
            PG8_BAR; PG8_WAIT_L(0); PG8_MMA(1, 0, At, B0); PG8_BAR; PG8_SCHED;
            PG8_STAGE(PG8_SB(1, 1), b3 + hstep, voffB);
            PG8_WAIT_V(6); PG8_BAR; PG8_MMA(1, 1, At, B1); PG8_BAR;
            }
        }
        if constexpr (ALIGN_EPI) { if (wr == 0) PG8_BAR; }
        if constexpr (!Epi::AFTER_DRAIN) { E(acc, cur, wr, wc, fr, fq); S.done(cur); }
        if (!has_next) break;
#pragma unroll
        for (int a = 0; a < 2; ++a)
#pragma unroll
            for (int b = 0; b < 2; ++b)
#pragma unroll
                for (int m = 0; m < 4; ++m)
#pragma unroll
                    for (int n = 0; n < 2; ++n) acc[a][b][m][n] = (f32x4){0.f, 0.f, 0.f, 0.f};
        cur = nxt; cA = nA; cB = nB; ++ui;
        if constexpr (ALIGN_EPI) { if (wr == 1) PG8_BAR; }
    }
    PG8_WAIT_V(0);
    if constexpr (!ALIGN_EPI) { if (wr == 0) PG8_BAR; }
    PG8_BAR;
    if constexpr (Epi::AFTER_DRAIN) { E.fused(acc, cur, wr, wc, fr, fq, lds, wid, lane); S.done(cur); }
#undef PG8_SA
#undef PG8_SB
#undef PG8_STAGE
#undef PG8_LDA
#undef PG8_LDB
#undef PG8_MMA
#undef PG8_WAIT_V
#undef PG8_WAIT_L
#undef PG8_BAR
#undef PG8_SCHED
}
}
constexpr int NWAVES = 8;
constexpr int BATCH = 2, SEQ = 8192, D = 1024, FF = 2816, M = BATCH * SEQ;
constexpr int N_IN = 3600, NIN_PAD = 3840, NGU = 2 * FF;
constexpr int GH = 4, GD = 128, GW = 512, AH = 8, AD = 64, AW = 512;
constexpr float EPS = 1e-6f;
constexpr size_t MiB = 1u << 20;
constexpr size_t WS_CTL = 0, CTL_ZERO_BYTES = 1 * MiB;
constexpr size_t WS_SS2 = 256 * 1024, WS_SS3 = 320 * 1024, WS_SS4 = 384 * 1024;
constexpr size_t WS_SS1 = 1 * MiB, WS_NWT = 1 * MiB + 65536;
constexpr size_t WS_WGU1 = 2 * MiB, WS_WD1 = 13 * MiB, WS_WIN = 19 * MiB, WS_WOUT = 27 * MiB, WS_WGU2 = 29 * MiB, WS_WD2 = 40 * MiB;
constexpr size_t WS_XB = 46 * MiB, WS_XB2 = 78 * MiB;
constexpr size_t WS_ACT = 110 * MiB;
constexpr size_t WS_QKVA = 110 * MiB, WS_Z = 158 * MiB, WS_QB = 174 * MiB, WS_KB = 190 * MiB, WS_VB = 206 * MiB, WS_AB = 222 * MiB;
constexpr size_t WS_IF = 29 * MiB, WS_SCAL = 45 * MiB, WS_WF = WS_XB, WS_UC = WS_XB2, WS_QF = 223 * MiB, WS_KT = 239 * MiB;
constexpr size_t WS_AO = WS_QKVA;
constexpr size_t WS_END = 256 * MiB;
constexpr int CW_BAR = 4096;
constexpr int RING_OFF = 0, RING_BYTES = 143360;
constexpr int LDSCTL_OFF = RING_BYTES, MISC_OFF = LDSCTL_OFF + 320;
constexpr int LDS_BYTES = 147456;
#define GAS __attribute__((address_space(1)))
#define LAS __attribute__((address_space(3)))
typedef unsigned short bf16;
typedef unsigned v4u __attribute__((ext_vector_type(4)));
typedef float f32x4 __attribute__((ext_vector_type(4)));
typedef short bf16x8 __attribute__((ext_vector_type(8)));
typedef GAS unsigned gu32;
typedef GAS unsigned long long gu64;
#define RLX_AGENT __ATOMIC_RELAXED, __HIP_MEMORY_SCOPE_AGENT
#define LDS_WAIT() asm volatile("s_waitcnt lgkmcnt(0)" ::: "memory")
#define VM_WAIT() asm volatile("s_waitcnt vmcnt(0)" ::: "memory")
__device__ __forceinline__ unsigned long long rt() { return __builtin_amdgcn_s_memrealtime(); }
__device__ __forceinline__ unsigned f2bf(float f) { unsigned u = __builtin_bit_cast(unsigned, f); return (u + 0x7fffu + ((u >> 16) & 1u)) >> 16; }
__device__ __forceinline__ unsigned pk2(float lo, float hi) { return f2bf(lo) | (f2bf(hi) << 16); }

#define XB_TMO      128
#define XB_XCNT(j)  (256  + 64 * (j))
#define XB_XSUB(j)  (1280 + 64 * (j))
#define XB_XGEN(j)  (2304 + 64 * (j))
#define XB_TOP      3328
#define XB_TOPGEN   3392
#define XCD_BAR_WORDS 3456
#define XB_SPIN_CAP (1u << 18)

__device__ __forceinline__ unsigned xb_ld(unsigned* p)              { return __hip_atomic_load(p, __ATOMIC_RELAXED, __HIP_MEMORY_SCOPE_AGENT); }
__device__ __forceinline__ unsigned xb_add(unsigned* p, unsigned v) { return __hip_atomic_fetch_add(p, v, __ATOMIC_RELAXED, __HIP_MEMORY_SCOPE_AGENT); }
__device__ __forceinline__ unsigned xb_xcc_id() { return (unsigned)__builtin_amdgcn_s_getreg((3 << 11) | 20) & 0xFu; }
#define XB_SPIN(cond, bar) do { unsigned _sp = 0; while (cond) { __builtin_amdgcn_s_sleep(1); \
    if ((++_sp & 255u) == 0u) { if (xb_ld(&(bar)[XB_TMO])) break; if (_sp > XB_SPIN_CAP) { atomicAdd(&(bar)[XB_TMO], 1u); break; } } } } while (0)

struct XcdBarrier {
    unsigned* bar; unsigned x;
    volatile LAS unsigned* st;
};

__device__ __forceinline__ XcdBarrier xcd_barrier_post(unsigned* bar, volatile LAS unsigned* st) {
    XcdBarrier b; b.bar = bar; b.x = xb_xcc_id(); b.st = st;
    if (threadIdx.x == 0) (void)xb_add(&bar[XB_XCNT(b.x)], 1u);
    return b;
}
__device__ __forceinline__ void xcd_barrier_complete(unsigned* bar, unsigned x, unsigned& nloc, unsigned& nx) {
    const unsigned G = gridDim.x * gridDim.y * gridDim.z;
    unsigned sum, cnt, mine, sp = 0u;
    for (;;) {
        sum = 0u; cnt = 0u; mine = 0u;
#pragma unroll
        for (unsigned j = 0; j < 16; ++j) { const unsigned c = xb_ld(&bar[XB_XCNT(j)]); sum += c; cnt += (c > 0u) ? 1u : 0u; mine = (j == x) ? c : mine; }
        if (sum == G) break;
        __builtin_amdgcn_s_sleep(1);
        if ((++sp & 255u) == 0u) { if (xb_ld(&bar[XB_TMO])) break; if (sp > XB_SPIN_CAP) { atomicAdd(&bar[XB_TMO], 1u); break; } }
    }
    nloc = mine > 0u ? mine : 1u; nx = cnt > 0u ? cnt : 1u;
}

__device__ __forceinline__ void xcd_barrier(const XcdBarrier& b) {
    asm volatile("s_waitcnt vmcnt(0)" ::: "memory");
    __syncthreads();
    if (threadIdx.x == 0) {
        unsigned* bar = b.bar;
        __builtin_amdgcn_s_waitcnt(0);
        unsigned nloc = b.st[0], nx = b.st[1];
        if (nloc == 0u) { xcd_barrier_complete(bar, b.x, nloc, nx); b.st[0] = nloc; b.st[1] = nx; }
        const unsigned old = xb_add(&bar[XB_XSUB(b.x)], 1u);
        const unsigned gen = old / nloc;
        if (old + 1u == (gen + 1u) * nloc) {
            __builtin_amdgcn_fence(__ATOMIC_RELEASE, "agent");
            asm volatile("s_waitcnt vmcnt(0)" ::: "memory");
            const unsigned og = xb_add(&bar[XB_TOP], 1u);
            const unsigned tg = og / nx;
            if (og + 1u == (tg + 1u) * nx) xb_add(&bar[XB_TOPGEN], 1u);
            else XB_SPIN(xb_ld(&bar[XB_TOPGEN]) == tg, bar);
            __builtin_amdgcn_fence(__ATOMIC_ACQUIRE, "agent");
            xb_add(&bar[XB_XGEN(b.x)], 1u);
            asm volatile("s_waitcnt vmcnt(0)" ::: "memory");
        } else {
            XB_SPIN(xb_ld(&bar[XB_XGEN(b.x)]) == gen, bar);
            __builtin_amdgcn_fence(__ATOMIC_ACQUIRE, "agent");
            asm volatile("s_waitcnt vmcnt(0)" ::: "memory");
        }
    }
    __syncthreads();
}

struct Args { const float* in[20]; float* out; unsigned char* ws; int ph_lo, ph_hi, li, pad; };
enum { IN_X = 0, IN_FFN1_NORM, IN_WG1, IN_WU1, IN_WD1, IN_MIX_NORM, IN_WIN, IN_CONVW, IN_ALOG, IN_DTBIAS, IN_GDN_NORM, IN_QNORM, IN_KNORM, IN_RELBIAS, IN_WOUT, IN_FFN2_NORM, IN_WG2, IN_WU2, IN_WD2, IN_FINAL_NORM };
struct Frame {
    LAS unsigned char* lds; volatile LAS unsigned* MISC; gu32* ctl;
    int wave, vcu, G;
};
#define DPP_ADD(v, ctrl) ((v) + __builtin_bit_cast(float, __builtin_amdgcn_mov_dpp(__builtin_bit_cast(int, (v)), (ctrl), 0xf, 0xf, true)))
__device__ __forceinline__ float row16_sum(float v) { v = DPP_ADD(v, 0xB1); v = DPP_ADD(v, 0x4E); v = DPP_ADD(v, 0x141); v = DPP_ADD(v, 0x140); return v; }
__device__ __forceinline__ float wave_sum(float v) {
    v = row16_sum(v);
    return ((__builtin_bit_cast(float, __builtin_amdgcn_readlane(__builtin_bit_cast(int, v), 0)) + __builtin_bit_cast(float, __builtin_amdgcn_readlane(__builtin_bit_cast(int, v), 16))) +
            (__builtin_bit_cast(float, __builtin_amdgcn_readlane(__builtin_bit_cast(int, v), 32)) + __builtin_bit_cast(float, __builtin_amdgcn_readlane(__builtin_bit_cast(int, v), 48))));
}
__device__ __forceinline__ float half32_sum(float v) { v = row16_sum(v); return v + __shfl_xor(v, 16); }
__device__ __forceinline__ float bf2f(unsigned short b) { return __builtin_bit_cast(float, (unsigned)b << 16); }

__device__ __forceinline__ void p0_transpose_item(const float* W, int ld, int k0, int n0, int nvalid, const float* scale, bf16* WT, int dstK, int row0, LAS float* scr, int lane) {
    const int c4 = (lane & 7) * 4, rr = lane >> 3;
#pragma unroll
    for (int i = 0; i < 8; ++i) { const int kk = 8 * i + rr; f32x4 v = (f32x4){0.f, 0.f, 0.f, 0.f};
        if (c4 < nvalid) v = *(const GAS f32x4*)(W + (size_t)(k0 + kk) * ld + n0 + c4);
        if (scale) v = v * scale[k0 + kk];
        LAS float* d = scr + kk * 33 + c4; d[0] = v.x; d[1] = v.y; d[2] = v.z; d[3] = v.w; }
    LDS_WAIT(); asm volatile("" ::: "memory");
    const int ch = lane & 7;
#pragma unroll
    for (int j = 0; j < 4; ++j) { const int n = (lane >> 3) + 8 * j; const LAS float* s = scr + (8 * ch) * 33 + n;
        v4u o; o.x = pk2(s[0 * 33], s[1 * 33]); o.y = pk2(s[2 * 33], s[3 * 33]); o.z = pk2(s[4 * 33], s[5 * 33]); o.w = pk2(s[6 * 33], s[7 * 33]);
        *(GAS v4u*)(WT + (size_t)(row0 + n) * dstK + k0 + 8 * ch) = o; }
    LDS_WAIT(); asm volatile("" ::: "memory");
}
constexpr int I_GU = (D / 64) * (NGU / 32), I_D = (FF / 64) * (D / 32), I_IN = (D / 64) * (NIN_PAD / 32), I_OUT = (D / 64) * (D / 32);
__device__ __forceinline__ void p0_weight_item(const Args& a, int which, int r, LAS float* scr, int lane) {
    unsigned char* ws = a.ws;
    if (r < I_GU) { const int kb = r / (NGU / 32), nb = r % (NGU / 32), pn = nb >> 3, q = nb & 7;
        const float* src = which ? ((q >> 2) ? a.in[IN_WU2] : a.in[IN_WG2]) : ((q >> 2) ? a.in[IN_WU1] : a.in[IN_WG1]);
        p0_transpose_item(src, FF, 64 * kb, 128 * pn + 32 * (q & 3), 32, (which ? a.in[IN_FFN2_NORM] : a.in[IN_FFN1_NORM]), (bf16*)(ws + (which ? WS_WGU2 : WS_WGU1)), D, 32 * nb, scr, lane); return; }
    r -= I_GU;
    if (r < I_D) { const int kb = r / (D / 32), nb = r % (D / 32);
        p0_transpose_item((which ? a.in[IN_WD2] : a.in[IN_WD1]), D, 64 * kb, 32 * nb, 32, nullptr, (bf16*)(ws + (which ? WS_WD2 : WS_WD1)), FF, 32 * nb, scr, lane); return; }
    r -= I_D;
    if (r < I_IN) { const int kb = r / (NIN_PAD / 32), nb = r % (NIN_PAD / 32), pn = nb >> 3, q = nb & 7; int n0 = 32 * nb, nvalid = 32;
        if (pn >= 14) { n0 = 2048; nvalid = (q == 0) ? 16 : 0; }
        else if (pn >= 8) { const int sec = (pn - 8) >> 1, half = (pn - 8) & 1, bj = q >> 2, wc = q & 3; n0 = 2064 + sec * 512 + (4 * half + wc) * 64 + 32 * bj; }
        p0_transpose_item(a.in[IN_WIN], N_IN, 64 * kb, n0, nvalid, a.in[IN_MIX_NORM], (bf16*)(ws + WS_WIN), D, 32 * nb, scr, lane); return; }
    r -= I_IN;
    { const int kb = r / (D / 32), nb = r % (D / 32);
        p0_transpose_item(a.in[IN_WOUT], D, 64 * kb, 32 * nb, 32, nullptr, (bf16*)(ws + WS_WOUT), D, 32 * nb, scr, lane); }
}
__device__ __forceinline__ void x_row_to_bf16(const float* xrow, bf16* orow, float* ssp, int lane) {
    const GAS f32x4* xr = (const GAS f32x4*)xrow + lane;
    f32x4 v[4]; float s = 0.f;
#pragma unroll
    for (int j = 0; j < 4; ++j) { v[j] = xr[64 * j]; s += (v[j].x * v[j].x + v[j].y * v[j].y) + (v[j].z * v[j].z + v[j].w * v[j].w); }
    s = wave_sum(s);
    GAS unsigned long long* o8 = (GAS unsigned long long*)orow + lane;
#pragma unroll
    for (int j = 0; j < 4; ++j) o8[64 * j] = (unsigned long long)pk2(v[j].x, v[j].y) | ((unsigned long long)pk2(v[j].z, v[j].w) << 32);
    if (lane == 0) *ssp = s;
}
__device__ __forceinline__ void final_norm_row(float* row, const float* w, float ss, int lane) {
    const float r = rsqrtf(ss * (1.0f / D) + EPS);
    GAS f32x4* p = (GAS f32x4*)row + lane; const GAS f32x4* wp = (const GAS f32x4*)w + lane;
#pragma unroll
    for (int j = 0; j < 4; ++j) { f32x4 v = p[64 * j]; const f32x4 ww = wp[64 * j]; v = v * ww * r; p[64 * j] = v; }
}


namespace gdn {
#ifdef TS_PROBE
#define PSTAMP(k) do { if (blockIdx.x == 0 && threadIdx.x == 0 && bh == 0 && c == 0) ((unsigned long long*)B.dbg)[512 + (k)] = __builtin_amdgcn_s_memrealtime(); } while (0)
#else
#define PSTAMP(k) do {} while (0)
#endif
typedef float f32x16 __attribute__((ext_vector_type(16)));
typedef float f32x4 __attribute__((ext_vector_type(4)));
typedef short bf16x8 __attribute__((ext_vector_type(8)));
typedef unsigned u32x4 __attribute__((ext_vector_type(4)));
typedef unsigned u32x2 __attribute__((ext_vector_type(2)));
constexpr int TS = 72;
constexpr int L_QS = 0, L_KS = 16384, L_KT = 32768, L_VT = 51200, L_LM = 69632, L_G = 106496, L_END = 108544;
constexpr int LM_BYTES = 18432;
typedef float f32x2_t __attribute__((ext_vector_type(2))); typedef __bf16 bf16x2_t __attribute__((ext_vector_type(2)));
__device__ __forceinline__ unsigned pkbf(float lo, float hi) { f32x2_t v = {lo, hi}; bf16x2_t b = __builtin_convertvector(v, bf16x2_t); return __builtin_bit_cast(unsigned, b); }
__device__ __forceinline__ bf16x8 pack8(const f32x16& x, int b) { u32x4 w; w.x = pkbf(x[b], x[b + 1]); w.y = pkbf(x[b + 2], x[b + 3]); w.z = pkbf(x[b + 4], x[b + 5]); w.w = pkbf(x[b + 6], x[b + 7]); return __builtin_bit_cast(bf16x8, w); }
__device__ __forceinline__ float lo2f(unsigned u) { return __builtin_bit_cast(float, u << 16); }
__device__ __forceinline__ float hi2f(unsigned u) { return __builtin_bit_cast(float, u & 0xffff0000u); }
__device__ __forceinline__ f32x16 mfma32(bf16x8 a, bf16x8 b, f32x16 c) { return __builtin_amdgcn_mfma_f32_32x32x16_bf16(a, b, c, 0, 0, 0); }
__device__ __forceinline__ int crow(int r, int hh) { return (r & 3) + 8 * (r >> 2) + 4 * hh; }
__device__ __forceinline__ int qk_off(int row, int d) { return row * 256 + ((((d >> 3) ^ (row & 15)) << 4) | ((d & 7) << 1)); }

struct Bufs { const bf16* qkva; const float* ab; bf16* Qf; bf16* Kt; bf16* Wf; bf16* If; bf16* Uc; float* Scal; unsigned* dbg; };
#ifdef GDN_DBG
#define DBGMAX(k, v) atomicMax(B.dbg + (k), __float_as_uint(v) & 0x7fffffffu)
#else
#define DBGMAX(k, v) do {} while (0)
#endif

__device__ __forceinline__ void prep_item(LAS unsigned char* lds, const Bufs& B, const float* conv_w, const float* a_log, const float* dt_bias, int bh, int c, int wave, int lane_in) {
    int lane = lane_in; asm volatile("" : "+v"(lane));
    const int b = bh >> 2, h = bh & 3, t0 = 64 * c;
    PSTAMP(13);
    {
        const bf16* src = B.qkva + (size_t)b * SEQ * 1536 + h * 128 + 2 * lane;
        float wq[3][2][5];
#pragma unroll
        for (int sec = 0; sec < 3; ++sec)
#pragma unroll
            for (int e = 0; e < 2; ++e)
#pragma unroll
                for (int j = 0; j < 5; ++j) wq[sec][e][j] = conv_w[(size_t)(sec * 512 + h * 128 + 2 * lane + e) * 5 + j];
        float xin[3][12][2];
#pragma unroll
        for (int rr = 0; rr < 12; ++rr) { const int t = t0 + 8 * wave - 2 + rr; const bool ok = (t >= 0) && (t < SEQ);
#pragma unroll
            for (int sec = 0; sec < 3; ++sec) { const unsigned u = ok ? *(const unsigned*)(src + (size_t)t * 1536 + sec * 512) : 0u; xin[sec][rr][0] = lo2f(u); xin[sec][rr][1] = hi2f(u); } }
        __builtin_amdgcn_sched_barrier(0);
    if (wave < 2) {
        const int dir = wave, t = t0 + lane; const float* abr = B.ab + ((size_t)b * SEQ + t) * 16;
        const float a = abr[dir * 4 + h] + dt_bias[dir * 4 + h];
        const float sp = (a > 20.f) ? a : log1pf(expf(a));
        float G = -expf(a_log[dir * 4 + h]) * sp;
        const float beta = 1.f / (1.f + expf(-abr[8 + dir * 4 + h]));
        if (dir == 0) {
#pragma unroll
            for (int o = 1; o < 64; o <<= 1) { const float n = __shfl_up(G, o); if (lane >= o) G += n; }
        } else {
#pragma unroll
            for (int o = 1; o < 64; o <<= 1) { const float n = __shfl_down(G, o); if (lane + o < 64) G += n; }
        }
        const float Gl = __shfl(G, dir ? 0 : 63);
        LAS float* gs = (LAS float*)(lds + L_G) + dir * 256;
        gs[lane] = G; gs[64 + lane] = beta; gs[128 + lane] = __expf(G); gs[192 + lane] = __expf(Gl - G);
        float* sc = B.Scal + ((size_t)(bh * 2 + dir) * 128 + c) * 128;
        sc[lane] = __expf(G); sc[64 + lane] = __expf(Gl - G);
    }
        __builtin_amdgcn_sched_barrier(0);
        unsigned ktp[2][4], vtp[2][4];
#pragma unroll
        for (int i = 0; i < 8; ++i) {
            float o[3][2];
#pragma unroll
            for (int sec = 0; sec < 3; ++sec)
#pragma unroll
                for (int e = 0; e < 2; ++e) { float s = 0.f;
#pragma unroll
                    for (int j = 0; j < 5; ++j) s += xin[sec][i + j][e] * wq[sec][e][j];
                    o[sec][e] = s / (1.f + __expf(-s)); }
            const float sq = wave_sum(o[0][0] * o[0][0] + o[0][1] * o[0][1]), sk = wave_sum(o[1][0] * o[1][0] + o[1][1] * o[1][1]);
            const float rq = rsqrtf(sq + EPS) * 0.08838834764831845f, rk = rsqrtf(sk + EPS);
            const int row = 8 * wave + i;
            *(LAS unsigned*)(lds + L_QS + qk_off(row, 2 * lane)) = pkbf(o[0][0] * rq, o[0][1] * rq);
            const unsigned kp = pkbf(o[1][0] * rk, o[1][1] * rk), vp = pkbf(o[2][0], o[2][1]);
            *(LAS unsigned*)(lds + L_KS + qk_off(row, 2 * lane)) = kp;
            if (i & 1) { ktp[0][i >> 1] |= kp << 16; ktp[1][i >> 1] |= kp & 0xffff0000u; vtp[0][i >> 1] |= vp << 16; vtp[1][i >> 1] |= vp & 0xffff0000u; }
            else { ktp[0][i >> 1] = kp & 0xffffu; ktp[1][i >> 1] = kp >> 16; vtp[0][i >> 1] = vp & 0xffffu; vtp[1][i >> 1] = vp >> 16; }
        }
#pragma unroll
        for (int e = 0; e < 2; ++e) {
            *(LAS u32x4*)(lds + L_KT + ((2 * lane + e) * TS + 8 * wave) * 2) = (u32x4){ktp[e][0], ktp[e][1], ktp[e][2], ktp[e][3]};
            *(LAS u32x4*)(lds + L_VT + ((2 * lane + e) * TS + 8 * wave) * 2) = (u32x4){vtp[e][0], vtp[e][1], vtp[e][2], vtp[e][3]};
        }
    }
    LDS_WAIT(); __syncthreads(); PSTAMP(14);
    {
        asm volatile("" : "+v"(lane)); const int r32 = lane & 31, hh = lane >> 5;
        const bool isKK = wave < 4; const int ta = (wave >> 1) & 1, tb = wave & 1;
        f32x16 acc = {};
#pragma unroll
        for (int ks = 0; ks < 8; ++ks) {
            const bf16x8 av = *(const LAS bf16x8*)(lds + L_KS + qk_off(32 * ta + r32, 16 * ks + 8 * hh));
            const bf16x8 bv = *(const LAS bf16x8*)(lds + (isKK ? L_KS : L_QS) + qk_off(32 * tb + r32, 16 * ks + 8 * hh));
            acc = mfma32(av, bv, acc);
        }
        const LAS float* g0 = (const LAS float*)(lds + L_G); const LAS float* g1 = g0 + 256;
        const int col = 32 * tb + r32;
        if (isKK) {
            const float G0j = g0[col], G1j = g1[col];
            LAS float* L0 = (LAS float*)(lds + L_LM); LAS float* L1 = (LAS float*)(lds + L_LM + LM_BYTES);
#pragma unroll
            for (int r = 0; r < 16; ++r) { const int i = 32 * ta + crow(r, hh);
                if (i > col) L0[i * TS + col] = g0[64 + i] * acc[r] * __expf(g0[i] - G0j);
                if (i < col) L1[(63 - i) * TS + (63 - col)] = g1[64 + i] * acc[r] * __expf(g1[i] - G1j); }
        } else {
            const float G0i = g0[col], G1i = g1[col];
            f32x16 v0, v1;
#pragma unroll
            for (int r = 0; r < 16; ++r) { const int j = 32 * ta + crow(r, hh);
                v0[r] = (col >= j) ? acc[r] * __expf(G0i - g0[j]) : 0.f;
                v1[r] = (col <= j) ? acc[r] * __expf(G1i - g1[j]) : 0.f; }
#pragma unroll
            for (int s = 0; s < 2; ++s) {
                *(bf16x8*)(B.If + ((((size_t)(bh * 2 + 0) * 128 + c) * 2 + tb) * 4 + 2 * ta + s) * 512 + lane * 8) = pack8(v0, 8 * s);
                *(bf16x8*)(B.If + ((((size_t)(bh * 2 + 1) * 128 + c) * 2 + tb) * 4 + 2 * ta + s) * 512 + lane * 8) = pack8(v1, 8 * s);
            }
        }
    }
    LDS_WAIT(); __syncthreads(); PSTAMP(15);
    {
        asm volatile("" : "+v"(lane));
        const int dir = wave >> 2, col = 16 * (wave & 3) + (lane >> 2), q = lane & 3;
        const LAS float* Lm = (const LAS float*)(lds + L_LM + dir * LM_BYTES);
        float T[16];
#pragma unroll
        for (int m = 0; m < 16; ++m) T[m] = 0.f;
        if (q == 0) T[0] = (col == 0) ? 1.f : 0.f;
        float lcur[16], lnxt[16];
        lcur[0] = Lm[1 * TS + q];
#pragma unroll
        for (int p = 1; p < 64; ++p) {
            const int nm = (p + 3) / 4, nmn = (p + 4) / 4;
            if (p < 63) {
#pragma unroll
                for (int m = 0; m < nmn; ++m) lnxt[m] = Lm[(p + 1) * TS + 4 * m + q];
            }
            float acc[4] = {0.f, 0.f, 0.f, 0.f};
#pragma unroll
            for (int m = 0; m < nm; ++m) { float lv = lcur[m]; if (4 * m + 3 >= p) lv = (4 * m + q < p) ? lv : 0.f; acc[m & 3] -= lv * T[m]; }
            float a = (acc[0] + acc[1]) + (acc[2] + acc[3]);
            a += __builtin_bit_cast(float, __builtin_amdgcn_mov_dpp(__builtin_bit_cast(int, a), 0xB1, 0xf, 0xf, true));
            a += __builtin_bit_cast(float, __builtin_amdgcn_mov_dpp(__builtin_bit_cast(int, a), 0x4E, 0xf, 0xf, true));
            if (q == (p & 3)) T[p >> 2] = a + ((col == p) ? 1.f : 0.f);
            if (p < 63) {
#pragma unroll
                for (int m = 0; m < nmn; ++m) lcur[m] = lnxt[m];
            }
        }
        const LAS float* gs = (const LAS float*)(lds + L_G) + dir * 256;
        const int j = dir ? 63 - col : col;
        const float bj = gs[64 + j], bej = bj * gs[128 + j];
        LDS_WAIT(); __syncthreads();
        LAS bf16* Tu = (LAS bf16*)(lds + L_LM + dir * LM_BYTES); LAS bf16* Tw = Tu + 64 * TS;
#pragma unroll
        for (int m = 0; m < 16; ++m) { const int p = 4 * m + q, i = dir ? 63 - p : p; Tu[i * TS + j] = (bf16)f2bf(T[m] * bj); Tw[i * TS + j] = (bf16)f2bf(T[m] * bej); }
    }
    PSTAMP(16);
#pragma unroll 1
    for (int f = wave; f < 32; f += 8) {
        asm volatile("" : "+v"(lane)); const int r32 = lane & 31, hh = lane >> 5;
        const bool isK = f >= 16; const int ff = f & 15;
        if (!isK) { const int mt = ff >> 3, ks = ff & 7, row = 32 * mt + r32;
            const u32x2 lo = *(const LAS u32x2*)(lds + L_QS + qk_off(row, 16 * ks + 4 * hh)), hi = *(const LAS u32x2*)(lds + L_QS + qk_off(row, 16 * ks + 8 + 4 * hh));
            *(u32x4*)(B.Qf + ((((size_t)bh * 128 + c) * 2 + mt) * 8 + ks) * 512 + lane * 8) = (u32x4){lo.x, lo.y, hi.x, hi.y};
        } else { const int mt = ff >> 2, ks = ff & 3, row = 32 * mt + r32;
            const u32x2 lo = *(const LAS u32x2*)(lds + L_KT + (row * TS + 16 * ks + 4 * hh) * 2), hi = *(const LAS u32x2*)(lds + L_KT + (row * TS + 16 * ks + 8 + 4 * hh) * 2);
            *(u32x4*)(B.Kt + ((((size_t)bh * 128 + c) * 4 + mt) * 4 + ks) * 512 + lane * 8) = (u32x4){lo.x, lo.y, hi.x, hi.y};
        }
    }
    LDS_WAIT(); __syncthreads(); PSTAMP(17);
#pragma unroll 1
    for (int k4 = 0; k4 < 4; ++k4) {
        asm volatile("" : "+v"(lane)); const int r32 = lane & 31, hh = lane >> 5;
        const int tt = wave * 4 + k4, dir = tt >> 4, kind = (tt >> 3) & 1, idx = tt & 7;
        const LAS unsigned char* Tu = lds + L_LM + dir * LM_BYTES; const LAS unsigned char* Tw = Tu + 64 * TS * 2;
        const size_t SC = (size_t)(bh * 2 + dir) * 128 + c;
        f32x16 acc = {};
        if (kind == 0) { const int mt = idx >> 2, dvt = idx & 3;
#pragma unroll
            for (int ks = 0; ks < 4; ++ks) { const bf16x8 a_ = *(const LAS bf16x8*)(Tu + ((32 * mt + r32) * TS + 16 * ks + 8 * hh) * 2), b_ = *(const LAS bf16x8*)(lds + L_VT + ((32 * dvt + r32) * TS + 16 * ks + 8 * hh) * 2);
#ifdef GDN_DBG
                for (int e_ = 0; e_ < 8; ++e_) { DBGMAX(0, bf2f((unsigned short)a_[e_])); DBGMAX(1, bf2f((unsigned short)b_[e_])); }
#endif
                acc = mfma32(a_, b_, acc); }
#ifdef GDN_DBG
            for (int e_ = 0; e_ < 16; ++e_) DBGMAX(2, acc[e_]);
#endif
            bf16* dst = B.Uc + ((SC * 4 + dvt) * 2 + mt) * 1024 + lane * 16;
            *(bf16x8*)dst = pack8(acc, 0); *(bf16x8*)(dst + 8) = pack8(acc, 8);
        } else { const int mtk = idx >> 1, ti = idx & 1;
#pragma unroll
            for (int ks = 0; ks < 4; ++ks) acc = mfma32(*(const LAS bf16x8*)(lds + L_KT + ((32 * mtk + r32) * TS + 16 * ks + 8 * hh) * 2), *(const LAS bf16x8*)(Tw + ((32 * ti + r32) * TS + 16 * ks + 8 * hh) * 2), acc);
#pragma unroll
            for (int s = 0; s < 2; ++s) *(bf16x8*)(B.Wf + (((SC * 2 + ti) * 8) + 2 * mtk + s) * 512 + lane * 8) = pack8(acc, 8 * s);
        }
    }
    LDS_WAIT(); __syncthreads(); PSTAMP(18);
}

__device__ __forceinline__ void scan_wave(const Bufs& B, int sq, int sl, int lane_in) {
    const int bh = sq >> 1, dir = sq & 1; int lane = lane_in;
    f32x16 S[4] = {};
#pragma unroll 1
    for (int step = 0; step < 128; ++step) {
        asm volatile("" : "+v"(lane)); const int hh = lane >> 5;
        const int c = dir ? 127 - step : step;
        const size_t SC = (size_t)sq * 128 + c, bhc = (size_t)bh * 128 + c;
        const float* sc = B.Scal + SC * 128;
        const unsigned lo16 = (unsigned)lane * 16u;
        const char* wfb = (const char*)(B.Wf + SC * 8192); const char* qfb = (const char*)(B.Qf + bhc * 8192); const char* ifb = (const char*)(B.If + SC * 4096); const char* ktb = (const char*)(B.Kt + bhc * 8192);
        char* ucb = (char*)(B.Uc + (SC * 4 + sl) * 2048);
        f32x16 Pw[2] = {}, Pq[2] = {};
#pragma unroll
        for (int ks = 0; ks < 8; ++ks) {
            const bf16x8 sb = pack8(S[ks >> 1], 8 * (ks & 1));
#pragma unroll
            for (int mt = 0; mt < 2; ++mt) {
                Pw[mt] = mfma32(*(const bf16x8*)(wfb + (mt * 8 + ks) * 1024 + lo16), sb, Pw[mt]);
                Pq[mt] = mfma32(*(const bf16x8*)(qfb + (mt * 8 + ks) * 1024 + lo16), sb, Pq[mt]);
            }
            if ((ks & 1) == 1) { asm volatile("" ::: "memory"); __builtin_amdgcn_sched_barrier(0); }
        }
        bf16x8 Vb[4], Vs[4];
#pragma unroll
        for (int mt = 0; mt < 2; ++mt) {
            const char* up = ucb + mt * 2048 + 2 * lo16;
            const u32x4 u0 = *(const u32x4*)up, u1 = *(const u32x4*)(up + 16);
            const unsigned uu[8] = {u0.x, u0.y, u0.z, u0.w, u1.x, u1.y, u1.z, u1.w};
            f32x16 vs;
#pragma unroll
            for (int g = 0; g < 4; ++g) {
                const f32x4 ek = *(const f32x4*)(sc + 64 + 32 * mt + 8 * g + 4 * hh);
#pragma unroll
                for (int e = 0; e < 4; ++e) { const int r = 4 * g + e; const float u = (r & 1) ? hi2f(uu[r >> 1]) : lo2f(uu[r >> 1]); Pw[mt][r] = u - Pw[mt][r]; vs[r] = Pw[mt][r] * ek[e]; }
            }
            Vb[2 * mt] = pack8(Pw[mt], 0); Vb[2 * mt + 1] = pack8(Pw[mt], 8); Vs[2 * mt] = pack8(vs, 0); Vs[2 * mt + 1] = pack8(vs, 8);
            asm volatile("" ::: "memory"); __builtin_amdgcn_sched_barrier(0);
        }
#pragma unroll
        for (int mt = 0; mt < 2; ++mt) {
#pragma unroll
            for (int g = 0; g < 4; ++g) { const f32x4 eg = *(const f32x4*)(sc + 32 * mt + 8 * g + 4 * hh);
#pragma unroll
                for (int e = 0; e < 4; ++e) Pq[mt][4 * g + e] *= eg[e]; }
#pragma unroll
            for (int ks = 0; ks < 4; ++ks) Pq[mt] = mfma32(*(const bf16x8*)(ifb + (mt * 4 + ks) * 1024 + lo16), Vb[ks], Pq[mt]);
            char* up = ucb + mt * 2048 + 2 * lo16;
            *(bf16x8*)up = pack8(Pq[mt], 0); *(bf16x8*)(up + 16) = pack8(Pq[mt], 8);
            asm volatile("" ::: "memory"); __builtin_amdgcn_sched_barrier(0);
        }
        const float a = sc[dir ? 0 : 63];
#pragma unroll
        for (int T = 0; T < 4; ++T) {
            S[T] = S[T] * a;
#pragma unroll
            for (int ks = 0; ks < 4; ++ks) S[T] = mfma32(*(const bf16x8*)(ktb + (T * 4 + ks) * 1024 + lo16), Vs[ks], S[T]);
            if (T & 1) { asm volatile("" ::: "memory"); __builtin_amdgcn_sched_barrier(0); }
        }
    }
}

constexpr int SL_WF = 0, SL_KT = 16384, SL_UC = 32768, SL_SC = 36864, SLOT_BYTES = 37888, NPIECE = 37, XCH_OFF = 3 * SLOT_BYTES, XCH_EG = 12288, XCH_BYTES = 12544, SCAN_LDS_END = XCH_OFF + 2 * XCH_BYTES;
static_assert(SCAN_LDS_END <= RING_BYTES, "scan LDS map");
#define SCAN_BAR() do { asm volatile("s_waitcnt lgkmcnt(0)" ::: "memory"); __builtin_amdgcn_s_barrier(); asm volatile("" ::: "memory"); } while (0)
__device__ __forceinline__ void scan_issue(LAS unsigned char* slot, const Bufs& B, int sq, int sl, int c, int wave, unsigned lo16) {
    const int bh = sq >> 1; const size_t SC = (size_t)sq * 128 + c, bhc = (size_t)bh * 128 + c;
    const char* wfb = (const char*)(B.Wf + SC * 8192); const char* ktb = (const char*)(B.Kt + bhc * 8192); const char* ucb = (const char*)(B.Uc + (SC * 4 + sl) * 2048); const char* scb = (const char*)(B.Scal + SC * 128);
#pragma unroll
    for (int k = 0; k < 8; ++k) { const int p = wave - 3 + 5 * k;
        if (p < NPIECE) { const char* src = p < 16 ? wfb + p * 1024 : (p < 32 ? ktb + (p - 16) * 1024 : (p < 36 ? ucb + (p - 32) * 1024 : scb));
            const int off = p < 16 ? SL_WF + p * 1024 : (p < 32 ? SL_KT + (p - 16) * 1024 : (p < 36 ? SL_UC + (p - 32) * 1024 : SL_SC));
            __builtin_amdgcn_global_load_lds((const unsigned*)(src + lo16), (LAS unsigned*)(slot + off), 16, 0, 0); } }
}
__device__ __forceinline__ void scan_wg(LAS unsigned char* lds, const Bufs& B, int sq, int sl, int wave, int lane_in) {
    const int dir = sq & 1, bh = sq >> 1; int lane = lane_in;
#define SCAN_C(s_) (dir ? 127 - (s_) : (s_))
    if (wave >= 3) {
        const unsigned lo16 = (unsigned)lane * 16u;
        scan_issue(lds, B, sq, sl, SCAN_C(0), wave, lo16); scan_issue(lds + SLOT_BYTES, B, sq, sl, SCAN_C(1), wave, lo16);
#pragma unroll 1
        for (int s = 0; s <= 128; ++s) {
            if (s < 127) { if (wave <= 4) asm volatile("s_waitcnt vmcnt(8)" ::: "memory"); else asm volatile("s_waitcnt vmcnt(7)" ::: "memory"); }
            else asm volatile("s_waitcnt vmcnt(0)" ::: "memory");
            SCAN_BAR();
            if (s + 2 < 128) { const int sl3 = (s + 2) % 3; scan_issue(lds + sl3 * SLOT_BYTES, B, sq, sl, SCAN_C(s + 2), wave, lo16); }
        }
        return;
    }
    if (wave >= 1) {
        const int mt = wave - 1;
        bf16x8 qfA[8], itA[4], qfB[8], itB[4];
        const unsigned lo16 = (unsigned)lane * 16u; const int hh = lane >> 5;
#define O_LOAD(QF, IT, s_) do { const int c_ = SCAN_C(s_); const size_t SC_ = (size_t)sq * 128 + c_, bhc_ = (size_t)bh * 128 + c_; \
            const char* qfb_ = (const char*)(B.Qf + bhc_ * 8192) + mt * 8192; const char* ifb_ = (const char*)(B.If + SC_ * 4096) + mt * 4096; \
            _Pragma("unroll") for (int i_ = 0; i_ < 8; ++i_) QF[i_] = *(const bf16x8*)(qfb_ + i_ * 1024 + lo16); \
            _Pragma("unroll") for (int i_ = 0; i_ < 4; ++i_) IT[i_] = *(const bf16x8*)(ifb_ + i_ * 1024 + lo16); } while (0)
#define O_STEP(QF, IT, sm1_) do { const LAS unsigned char* xch = lds + XCH_OFF + ((sm1_) & 1) * XCH_BYTES; \
            f32x16 Pq = {}; \
            _Pragma("unroll") for (int ks = 0; ks < 8; ++ks) Pq = mfma32(QF[ks], *(const LAS bf16x8*)(xch + ks * 1024 + lo16), Pq); \
            _Pragma("unroll") for (int g = 0; g < 4; ++g) { const f32x4 eg = *(const LAS f32x4*)(xch + XCH_EG + (32 * mt + 8 * g + 4 * hh) * 4); \
                _Pragma("unroll") for (int e = 0; e < 4; ++e) Pq[4 * g + e] *= eg[e]; } \
            _Pragma("unroll") for (int ks = 0; ks < 4; ++ks) Pq = mfma32(IT[ks], *(const LAS bf16x8*)(xch + 8192 + ks * 1024 + lo16), Pq); \
            char* up = (char*)(B.Uc + (((size_t)sq * 128 + SCAN_C(sm1_)) * 4 + sl) * 2048) + mt * 2048 + 2 * lo16; \
            *(bf16x8*)up = pack8(Pq, 0); *(bf16x8*)(up + 16) = pack8(Pq, 8); } while (0)
        O_LOAD(qfA, itA, 0); O_LOAD(qfB, itB, 1);
        SCAN_BAR();
#pragma unroll 1
        for (int s = 1; s <= 128; s += 2) {
            SCAN_BAR();
            asm volatile("" : "+v"(qfA[0]), "+v"(itA[0])); O_STEP(qfA, itA, s - 1); if (s + 1 < 128) O_LOAD(qfA, itA, s + 1);
            SCAN_BAR();
            asm volatile("" : "+v"(qfB[0]), "+v"(itB[0])); O_STEP(qfB, itB, s); if (s + 2 < 128) O_LOAD(qfB, itB, s + 2);
        }
#undef O_LOAD
#undef O_STEP
        return;
    }
    f32x16 S[4] = {};
#pragma unroll 1
    for (int step = 0; step <= 128; ++step) {
        SCAN_BAR();
        if (step == 128) break;
        LAS unsigned char* slot = lds + (step % 3) * SLOT_BYTES;
        LAS unsigned char* xch = lds + XCH_OFF + (step & 1) * XCH_BYTES;
        asm volatile("" : "+v"(lane)); const int hh = lane >> 5;
        const unsigned lo16 = (unsigned)lane * 16u;
        const LAS float* sc = (const LAS float*)(slot + SL_SC);
        bf16x8 wf[16];
#pragma unroll
        for (int i = 0; i < 16; ++i) wf[i] = *(const LAS bf16x8*)(slot + SL_WF + i * 1024 + lo16);
        u32x4 uraw[4];
#pragma unroll
        for (int i = 0; i < 4; ++i) uraw[i] = *(const LAS u32x4*)(slot + SL_UC + (i >> 1) * 2048 + 2 * lo16 + (i & 1) * 16);
        f32x4 ekv[8];
#pragma unroll
        for (int i = 0; i < 8; ++i) ekv[i] = *(const LAS f32x4*)(sc + 64 + 32 * (i >> 2) + 8 * (i & 3) + 4 * hh);
        const float a = sc[dir ? 0 : 63];
        if (lane < 16) *(LAS f32x4*)(xch + XCH_EG + lane * 16) = *(const LAS f32x4*)(sc + 4 * lane);
        __builtin_amdgcn_sched_barrier(0);
        bf16x8 sb[8];
#pragma unroll
        for (int ks = 0; ks < 8; ++ks) { sb[ks] = pack8(S[ks >> 1], 8 * (ks & 1)); *(LAS bf16x8*)(xch + ks * 1024 + lo16) = sb[ks]; }
        f32x16 Pw0 = {}, Pw1 = {};
#pragma unroll
        for (int ks = 0; ks < 8; ++ks) Pw0 = mfma32(wf[ks], sb[ks], Pw0);
#pragma unroll
        for (int T = 0; T < 4; ++T) S[T] = S[T] * a;
#pragma unroll
        for (int ks = 0; ks < 8; ++ks) Pw1 = mfma32(wf[8 + ks], sb[ks], Pw1);
        bf16x8 kt[16];
#pragma unroll
        for (int i = 0; i < 16; ++i) kt[i] = *(const LAS bf16x8*)(slot + SL_KT + i * 1024 + lo16);
        bf16x8 Vs[4];
#define R_VALU(PW, mt_) do { const unsigned uu[8] = {uraw[2 * (mt_)].x, uraw[2 * (mt_)].y, uraw[2 * (mt_)].z, uraw[2 * (mt_)].w, uraw[2 * (mt_) + 1].x, uraw[2 * (mt_) + 1].y, uraw[2 * (mt_) + 1].z, uraw[2 * (mt_) + 1].w}; \
            f32x16 vs; \
            _Pragma("unroll") for (int g = 0; g < 4; ++g) _Pragma("unroll") for (int e = 0; e < 4; ++e) { const int r = 4 * g + e; const float u = (r & 1) ? hi2f(uu[r >> 1]) : lo2f(uu[r >> 1]); PW[r] = u - PW[r]; vs[r] = PW[r] * ekv[4 * (mt_) + g][e]; } \
            *(LAS bf16x8*)(xch + 8192 + (2 * (mt_)) * 1024 + lo16) = pack8(PW, 0); *(LAS bf16x8*)(xch + 8192 + (2 * (mt_) + 1) * 1024 + lo16) = pack8(PW, 8); \
            Vs[2 * (mt_)] = pack8(vs, 0); Vs[2 * (mt_) + 1] = pack8(vs, 8); } while (0)
        R_VALU(Pw0, 0);
#pragma unroll
        for (int T = 0; T < 4; ++T)
#pragma unroll
            for (int k2 = 0; k2 < 2; ++k2) S[T] = mfma32(kt[T * 4 + k2], Vs[k2], S[T]);
        R_VALU(Pw1, 1);
#pragma unroll
        for (int T = 0; T < 4; ++T)
#pragma unroll
            for (int k2 = 2; k2 < 4; ++k2) S[T] = mfma32(kt[T * 4 + k2], Vs[k2], S[T]);
#undef R_VALU
    }
#undef SCAN_C
}

__device__ __forceinline__ void finalize_item(const Bufs& B, const bf16* Z, const float* nw, bf16* XBo, int item, int lane) {
    const int Tt = item & 1, c = (item >> 1) & 127, bh = item >> 8, b = bh >> 2, h = bh & 3, r32 = lane & 31, hh = lane >> 5;
    float o[4][16];
#pragma unroll
    for (int sl = 0; sl < 4; ++sl) {
        const bf16* p0 = B.Uc + ((((size_t)(bh * 2 + 0) * 128 + c) * 4 + sl) * 2 + Tt) * 1024 + lane * 16;
        const bf16* p1 = B.Uc + ((((size_t)(bh * 2 + 1) * 128 + c) * 4 + sl) * 2 + Tt) * 1024 + lane * 16;
        const u32x4 a0 = *(const u32x4*)p0, a1 = *(const u32x4*)(p0 + 8), b0 = *(const u32x4*)p1, b1 = *(const u32x4*)(p1 + 8);
        const unsigned ua[8] = {a0.x, a0.y, a0.z, a0.w, a1.x, a1.y, a1.z, a1.w}, ub[8] = {b0.x, b0.y, b0.z, b0.w, b1.x, b1.y, b1.z, b1.w};
#pragma unroll
        for (int r = 0; r < 16; ++r) o[sl][r] = ((r & 1) ? hi2f(ua[r >> 1]) : lo2f(ua[r >> 1])) + ((r & 1) ? hi2f(ub[r >> 1]) : lo2f(ub[r >> 1]));
    }
    float nwv[4];
#pragma unroll
    for (int sl = 0; sl < 4; ++sl) nwv[sl] = nw[32 * sl + r32];
    const size_t rowb = (size_t)b * SEQ + 64 * c + 32 * Tt + 4 * hh;
#pragma unroll
    for (int r = 0; r < 16; ++r) {
        float s = (o[0][r] * o[0][r] + o[1][r] * o[1][r]) + (o[2][r] * o[2][r] + o[3][r] * o[3][r]);
        s = half32_sum(s);
        const float rn = rsqrtf(s * (1.0f / 128.0f) + EPS);
        const size_t row = rowb + (r & 3) + 8 * (r >> 2);
        const bf16* zp = Z + row * 512 + h * 128 + r32; bf16* xp = XBo + row * D + h * 128 + r32;
#pragma unroll
        for (int sl = 0; sl < 4; ++sl) { const float z = bf2f(zp[32 * sl]); xp[32 * sl] = (bf16)f2bf(o[sl][r] * rn * nwv[sl] * (z / (1.f + __expf(-z)))); }
        if ((r & 1) == 1) asm volatile("" ::: "memory");
    }
}
}

namespace attn {
using gdn::f32x16; using gdn::bf16x8; using gdn::mfma32; using gdn::pack8; using gdn::crow; using gdn::f32x4; using gdn::u32x4;
typedef short s16x4 __attribute__((ext_vector_type(4)));
constexpr int A_OACC = 0, A_L = 65536, A_BIAS = 66560, A_V = 68608, A_END = A_V + 8 * 8192;
__device__ const unsigned char BUCKET[3][129] = {
 {11,11,11,11,11,11,11,11,11,11,11,11,11,11,11,10,10,10,10,10,10,10,10,10,10,10,10,10,10,10,10,10,10,10,10,10,10,10,9,9,9,9,9,9,9,9,9,9,9,9,8,8,8,8,8,8,8,7,6,5,4,3,2,1,0,17,18,19,20,21,22,23,24,24,24,24,24,24,24,25,25,25,25,25,25,25,25,25,25,25,25,26,26,26,26,26,26,26,26,26,26,26,26,26,26,26,26,26,26,26,26,26,26,26,27,27,27,27,27,27,27,27,27,27,27,27,27,27,27},
 {13,13,13,13,13,13,13,13,13,13,13,13,13,13,13,13,13,13,13,13,13,13,13,12,12,12,12,12,12,12,12,12,12,12,12,12,12,12,12,12,12,12,11,11,11,11,11,11,11,11,11,11,10,10,10,10,10,10,9,9,9,8,8,4,0,20,24,24,25,25,25,26,26,26,26,26,26,27,27,27,27,27,27,27,27,27,27,28,28,28,28,28,28,28,28,28,28,28,28,28,28,28,28,28,28,28,29,29,29,29,29,29,29,29,29,29,29,29,29,29,29,29,29,29,29,29,29,29,29},
 {15,15,15,15,15,15,15,15,15,15,15,15,15,15,15,15,15,15,15,15,15,15,15,15,15,15,15,15,15,15,14,14,14,14,14,14,14,14,14,14,14,14,14,14,14,13,13,13,13,13,13,13,13,13,12,12,12,12,12,11,11,10,10,9,0,25,26,26,27,27,28,28,28,28,28,29,29,29,29,29,29,29,29,29,30,30,30,30,30,30,30,30,30,30,30,30,30,30,30,31,31,31,31,31,31,31,31,31,31,31,31,31,31,31,31,31,31,31,31,31,31,31,31,31,31,31,31,31,31}};
__device__ __forceinline__ s16x4 vtr(const LAS unsigned char* p) { return __builtin_bit_cast(s16x4, __builtin_amdgcn_ds_read_tr16_b64_v4i16((LAS s16x4*)p)); }

template <int PASS>
__device__ __forceinline__ void unit_pass(LAS unsigned char* lds, const bf16* Qbh, const bf16* Kbh, const bf16* Vbh, int T0, int wave, int lane_in) {
    constexpr int d = PASS == 0 ? 1 : (PASS == 1 ? 4 : 16), dsh = PASS == 0 ? 0 : (PASS == 1 ? 2 : 4), NBLK = PASS == 2 ? 10 : 5;
    int lane = lane_in; asm volatile("" : "+v"(lane));
    const int r32 = lane & 31, hh = lane >> 5;
    auto qloc = [&](int i) -> int { return PASS == 0 ? 32 * wave + i : (PASS == 1 ? (wave & 3) + 4 * (32 * (wave >> 2) + i) : 2 * wave + (i >> 4) + 16 * (i & 15)); };
    const int tq = T0 + qloc(r32);
    bf16x8 qf[4];
#pragma unroll
    for (int ks = 0; ks < 4; ++ks) qf[ks] = *(const bf16x8*)(Qbh + (size_t)tq * 512 + 16 * ks + 8 * hh);
    const LAS float* bias = (const LAS float*)(lds + A_BIAS) + PASS * 132;
    LAS unsigned char* vst = lds + A_V + wave * 8192;
    const LAS unsigned char* vrd = vst + ((lane >> 4) & 1) * 32 + (lane & 3) * 8 + (4 * hh + ((lane & 15) >> 2)) * 64;
    f32x16 o[2] = {}; float lp = 0.f;
    auto kbase_of = [&](int blk) -> int {
        return PASS == 0 ? T0 + 32 * wave + 32 * (blk - 2) : (PASS == 1 ? T0 + (wave & 3) + 4 * (32 * (wave >> 2) + 32 * (blk - 2)) : T0 + 2 * wave + (blk >= 5 ? 1 : 0) + 16 * 32 * ((blk >= 5 ? blk - 5 : blk) - 2)); };
#define ATTN_ISSUE(KF, STG, blk_) do { const int kb_ = kbase_of(blk_); \
        _Pragma("unroll") for (int pc = 0; pc < 4; ++pc) { const int d0 = pc >> 1, kg = pc & 1; int kt = kb_ + d * (16 * kg + (lane >> 2)); kt = kt < 0 ? 0 : (kt > SEQ - 1 ? SEQ - 1 : kt); \
            __builtin_amdgcn_global_load_lds((const unsigned*)(Vbh + (size_t)kt * 512 + 32 * d0 + (lane & 3) * 8), (LAS unsigned*)(vst + (STG) * 4096 + pc * 1024), 16, 0, 0); } \
        int ktr = kb_ + d * r32; ktr = ktr < 0 ? 0 : (ktr > SEQ - 1 ? SEQ - 1 : ktr); \
        _Pragma("unroll") for (int ks = 0; ks < 4; ++ks) KF[ks] = *(const bf16x8*)(Kbh + (size_t)ktr * 512 + 16 * ks + 8 * hh); } while (0)
#define ATTN_BLOCK(KF, STG, blk_) do { const int kbase = kbase_of(blk_); \
        f32x16 acc = {}; \
        _Pragma("unroll") for (int ks = 0; ks < 4; ++ks) acc = mfma32(KF[ks], qf[ks], acc); \
        f32x16 p; \
        _Pragma("unroll") for (int r = 0; r < 16; ++r) { \
            const int kt = kbase + d * crow(r, hh), rel = kt - tq; \
            const bool ok = (kt >= 0) && (kt < SEQ) && ((rel & (d - 1)) == 0) && (rel >= -64 * d) && (rel <= 64 * d); \
            const float bv = bias[ok ? (rel >> dsh) + 64 : 64]; \
            p[r] = ok ? __expf(acc[r] + bv) : 0.f; lp += p[r]; } \
        _Pragma("unroll") for (int s = 0; s < 2; ++s) { const bf16x8 pa = pack8(p, 8 * s); \
            _Pragma("unroll") for (int d0 = 0; d0 < 2; ++d0) { \
                const s16x4 lo = vtr(vrd + (STG) * 4096 + d0 * 2048 + s * 1024), hi = vtr(vrd + (STG) * 4096 + d0 * 2048 + s * 1024 + 512); \
                const bf16x8 vf = (bf16x8){lo[0], lo[1], lo[2], lo[3], hi[0], hi[1], hi[2], hi[3]}; \
                o[d0] = mfma32(pa, vf, o[d0]); } } } while (0)
#define ATTN_LANDED(KF) do { asm volatile("s_waitcnt vmcnt(0) lgkmcnt(0)" ::: "memory"); asm volatile("" : "+v"(KF[0]), "+v"(KF[1]), "+v"(KF[2]), "+v"(KF[3])); __builtin_amdgcn_sched_barrier(0); } while (0)
    bf16x8 kfA[4], kfB[4];
    ATTN_ISSUE(kfA, 0, 0);
#pragma unroll 1
    for (int blk = 0; blk < NBLK - 1; blk += 2) {
        ATTN_LANDED(kfA); ATTN_ISSUE(kfB, 1, blk + 1); ATTN_BLOCK(kfA, 0, blk);
        ATTN_LANDED(kfB); if (blk + 2 < NBLK) ATTN_ISSUE(kfA, 0, blk + 2); ATTN_BLOCK(kfB, 1, blk + 1);
    }
    if (NBLK & 1) { ATTN_LANDED(kfA); ATTN_BLOCK(kfA, 0, NBLK - 1); }
#undef ATTN_ISSUE
#undef ATTN_BLOCK
#undef ATTN_LANDED
    lp += __shfl_xor(lp, 32);
    LAS float* Oacc = (LAS float*)(lds + A_OACC); LAS float* Lacc = (LAS float*)(lds + A_L);
    if (hh == 0) { const int ql = qloc(r32); if (PASS == 0) Lacc[ql] = lp; else Lacc[ql] += lp; }
#pragma unroll
    for (int r = 0; r < 16; ++r) { const int ql = qloc(crow(r, hh));
#pragma unroll
        for (int d0 = 0; d0 < 2; ++d0) { LAS float* dst = Oacc + ql * 64 + 32 * d0 + r32; if (PASS == 0) *dst = o[d0][r]; else *dst += o[d0][r]; } }
    asm volatile("s_waitcnt vmcnt(0) lgkmcnt(0)" ::: "memory"); __syncthreads();
}

__device__ __forceinline__ void unit(LAS unsigned char* lds, const bf16* QB, const bf16* KB, const bf16* VB, const float* rel_bias, bf16* AO, int u, int wave, int lane) {
    const int bh = u >> 5, b = bh >> 3, h = bh & 7, T0 = (u & 31) * 256;
    for (int i = threadIdx.x; i < 387; i += NWAVES * 64) { const int p = i / 129, jj = i - 129 * p; ((LAS float*)(lds + A_BIAS))[p * 132 + jj] = rel_bias[(int)BUCKET[p][jj] * AH + h]; }
    asm volatile("s_waitcnt vmcnt(0) lgkmcnt(0)" ::: "memory"); __syncthreads();
    const size_t hb = (size_t)b * SEQ * 512 + h * 64;
    unit_pass<0>(lds, QB + hb, KB + hb, VB + hb, T0, wave, lane);
    unit_pass<1>(lds, QB + hb, KB + hb, VB + hb, T0, wave, lane);
    unit_pass<2>(lds, QB + hb, KB + hb, VB + hb, T0, wave, lane);
    {
        const int tl = threadIdx.x >> 1, half = threadIdx.x & 1;
        const LAS f32x4* src = (const LAS f32x4*)(lds + A_OACC + (tl * 64 + 32 * half) * 4);
        const float rl = 1.0f / ((const LAS float*)(lds + A_L))[tl];
        bf16* dst = AO + ((size_t)b * SEQ + T0 + tl) * 512 + h * 64 + 32 * half;
#pragma unroll
        for (int q4 = 0; q4 < 4; ++q4) { const f32x4 x0 = src[2 * q4] * rl, x1 = src[2 * q4 + 1] * rl;
            *(u32x4*)(dst + 8 * q4) = (u32x4){gdn::pkbf(x0[0], x0[1]), gdn::pkbf(x0[2], x0[3]), gdn::pkbf(x1[0], x1[1]), gdn::pkbf(x1[2], x1[3])}; }
    }
    asm volatile("s_waitcnt lgkmcnt(0)" ::: "memory"); __syncthreads();
}
}
constexpr int N_PHASES = 11;
__global__ void __launch_bounds__(NWAVES * 64, 2) mk_fwd(Args args) {
    extern __shared__ __attribute__((aligned(16))) unsigned char lds[];
    Frame F;
    F.lds = (LAS unsigned char*)lds; F.MISC = (volatile LAS unsigned*)(F.lds + MISC_OFF);
    F.wave = __builtin_amdgcn_readfirstlane((int)threadIdx.x >> 6);
    F.G = gridDim.x; { const int bx = blockIdx.x; F.vcu = (F.G % 8 == 0) ? (bx % 8) * (F.G / 8) + bx / 8 : bx; }
    unsigned char* ws = args.ws;
    F.ctl = (gu32*)(ws + WS_CTL);
    for (int u = (int)threadIdx.x; u < (LDS_BYTES - LDSCTL_OFF) / 4; u += NWAVES * 64) ((LAS unsigned*)(F.lds + LDSCTL_OFF))[u] = 0u;
    __syncthreads();
    XcdBarrier bar = xcd_barrier_post((unsigned*)(F.ctl + CW_BAR) + args.li * XCD_BAR_WORDS, F.MISC + 8);
    const int lo = args.ph_lo, hi = args.ph_hi;
#define IN(k) (lo <= (k) && (k) < hi)
#ifdef TS_PROBE
    unsigned long long* const tsw = (unsigned long long*)(ws + 212 * 1024);
#define STAMP(k) do { if (blockIdx.x == 0 && threadIdx.x == 0) tsw[k] = __builtin_amdgcn_s_memrealtime(); } while (0)
#else
#define STAMP(k) do {} while (0)
#endif
#define SEAM(k) do { if (IN(k) && IN((k) + 1)) xcd_barrier(bar); STAMP((k) + 1); } while (0)
    STAMP(0);
    bf16* XB = (bf16*)(ws + WS_XB); bf16* XB2 = (bf16*)(ws + WS_XB2); bf16* ACT = (bf16*)(ws + WS_ACT);
    float* SS1 = (float*)(ws + WS_SS1); float* SS2 = (float*)(ws + WS_SS2); float* SS3 = (float*)(ws + WS_SS3); float* SS4 = (float*)(ws + WS_SS4);
    const int gw = F.vcu * NWAVES + F.wave, NGW = F.G * NWAVES;

    if (IN(0)) {
        LAS float* scr = (LAS float*)(F.lds + RING_OFF + F.wave * 16384);
        constexpr int NITEMS = I_GU + I_D + I_IN + I_OUT;
        for (int it = gw; it < NITEMS; it += NGW) p0_weight_item(args, 0, it, scr, (int)(threadIdx.x & 63));
        if (blockIdx.x == 0 && (int)threadIdx.x < 192) { float* nwt = (float*)(ws + WS_NWT); nwt[(int)threadIdx.x] = (int)threadIdx.x < 64 ? args.in[IN_QNORM][(int)threadIdx.x] * 0.125f : ((int)threadIdx.x < 128 ? args.in[IN_KNORM][(int)threadIdx.x - 64] : 1.0f); }
        for (int m = gw; m < M; m += NGW) x_row_to_bf16(args.in[IN_X] + (size_t)m * D, XB + (size_t)m * D, SS1 + m, (int)(threadIdx.x & 63));
    }
    SEAM(0);
    if (IN(1)) {
        pg8::Gemm g{XB, (const bf16*)(ws + WS_WGU1), M, NGU, D}; pg8::StaticOrder S; S.init(M, NGU, F.G, (int)blockIdx.x);
        pg8::EpiSwiGLU E{ACT, FF, SS1};
        pg8::gemm_phase<pg8::EpiSwiGLU, pg8::StaticOrder, true, true>(F.lds + RING_OFF, g, S, E);
    }
    SEAM(1);
    if (IN(2)) {
        pg8::Gemm g{ACT, (const bf16*)(ws + WS_WD1), M, D, FF}; pg8::StaticOrder S; S.init(M, D, F.G, (int)blockIdx.x);
        pg8::EpiResid E{args.in[IN_X], args.out, XB, SS2, 0.5f};
        pg8::gemm_phase<pg8::EpiResid, pg8::StaticOrder, true, true>(F.lds + RING_OFF, g, S, E);
    }
    SEAM(2);
    if (IN(3)) {
        pg8::Gemm g{XB, (const bf16*)(ws + WS_WIN), M, NIN_PAD, D}; pg8::StaticOrder S; S.init(M, NIN_PAD, F.G, (int)blockIdx.x);
        pg8::EpiProj E{(bf16*)(ws + WS_QKVA), (bf16*)(ws + WS_QB), (float*)(ws + WS_AB), SS2, (const float*)(ws + WS_NWT)};
        pg8::gemm_phase<pg8::EpiProj, pg8::StaticOrder, true, true>(F.lds + RING_OFF, g, S, E);
    }
    SEAM(3);
    const gdn::Bufs GB{(const bf16*)(ws + WS_QKVA), (const float*)(ws + WS_AB), (bf16*)(ws + WS_QF), (bf16*)(ws + WS_KT), (bf16*)(ws + WS_WF), (bf16*)(ws + WS_IF), (bf16*)(ws + WS_UC), (float*)(ws + WS_SCAL), (unsigned*)(ws + 208 * 1024)};
    if (IN(4)) {
        for (int it = blockIdx.x; it < 8 * 128; it += F.G) gdn::prep_item(F.lds + RING_OFF, GB, args.in[IN_CONVW], args.in[IN_ALOG], args.in[IN_DTBIAS], it >> 7, it & 127, F.wave, (int)(threadIdx.x & 63));
    }
    SEAM(4);
    if (IN(5)) {
        constexpr int NSCAN = 64;
        if (blockIdx.x < NSCAN) { gdn::scan_wg(F.lds + RING_OFF, GB, (int)blockIdx.x >> 2, (int)blockIdx.x & 3, F.wave, (int)(threadIdx.x & 63)); STAMP(12); }
        else for (int u = (int)blockIdx.x - NSCAN; u < 512; u += F.G - NSCAN)
        {
            attn::unit(F.lds + RING_OFF, (const bf16*)(ws + WS_QB), (const bf16*)(ws + WS_KB), (const bf16*)(ws + WS_VB), args.in[IN_RELBIAS], (bf16*)(ws + WS_AO), u, F.wave, (int)(threadIdx.x & 63));
#ifdef ATTN_TWICE
            attn::unit(F.lds + RING_OFF, (const bf16*)(ws + WS_QB), (const bf16*)(ws + WS_KB), (const bf16*)(ws + WS_VB), args.in[IN_RELBIAS], (bf16*)(ws + WS_AO), u, F.wave, (int)(threadIdx.x & 63));
#endif
        }
    }
    SEAM(5);
    if (IN(6)) {
        for (int it = gw; it < 8 * 128 * 2; it += NGW) gdn::finalize_item(GB, (const bf16*)(ws + WS_Z), args.in[IN_GDN_NORM], XB, it, (int)(threadIdx.x & 63));
        for (int m = gw; m < M; m += NGW) *(GAS v4u*)(XB + (size_t)m * D + 512 + (threadIdx.x & 63) * 8) = *(const GAS v4u*)((const bf16*)(ws + WS_AO) + (size_t)m * 512 + (threadIdx.x & 63) * 8);
        LAS float* scr = (LAS float*)(F.lds + RING_OFF + F.wave * 16384);
        for (int it = gw; it < I_GU + I_D; it += NGW) p0_weight_item(args, 1, it, scr, (int)(threadIdx.x & 63));
    }
    SEAM(6);
    if (IN(7)) {
        pg8::Gemm g{XB, (const bf16*)(ws + WS_WOUT), M, D, D}; pg8::StaticOrder S; S.init(M, D, F.G, (int)blockIdx.x);
        pg8::EpiResid E{args.out, args.out, XB2, SS3, 1.0f};
        pg8::gemm_phase<pg8::EpiResid, pg8::StaticOrder, true, true>(F.lds + RING_OFF, g, S, E);
    }
    SEAM(7);
    if (IN(8)) {
        pg8::Gemm g{XB2, (const bf16*)(ws + WS_WGU2), M, NGU, D}; pg8::StaticOrder S; S.init(M, NGU, F.G, (int)blockIdx.x);
        pg8::EpiSwiGLU E{ACT, FF, SS3};
        pg8::gemm_phase<pg8::EpiSwiGLU, pg8::StaticOrder, true, true>(F.lds + RING_OFF, g, S, E);
    }
    SEAM(8);
    if (IN(9)) {
        pg8::Gemm g{ACT, (const bf16*)(ws + WS_WD2), M, D, FF}; pg8::StaticOrder S; S.init(M, D, F.G, (int)blockIdx.x);
        pg8::EpiResid E{args.out, args.out, nullptr, SS4, 0.5f};
        pg8::gemm_phase<pg8::EpiResid, pg8::StaticOrder, true, true>(F.lds + RING_OFF, g, S, E);
    }
    SEAM(9);
    if (IN(10)) {
        for (int m = gw; m < M; m += NGW) final_norm_row(args.out + (size_t)m * D, args.in[IN_FINAL_NORM], SS4[m], (int)(threadIdx.x & 63));
    }
#ifdef TS_PROBE
    xcd_barrier(bar); STAMP(11);
    asm volatile("s_waitcnt vmcnt(0)" ::: "memory"); __syncthreads();
    { const float dl = (float)(tsw[TS_TO] - tsw[TS_FROM]) * 0.01f * (1.0f / TS_SCALE);
      for (size_t i = (size_t)blockIdx.x * 512 + threadIdx.x; i < ((size_t)1 << 20); i += (size_t)gridDim.x * 512) args.out[1 + i] += dl; }
#endif
#undef IN
#undef SEAM
}

namespace ref {
constexpr int CONVW = 5;
__device__ const unsigned char BUCKET[3][129] = {
 {11,11,11,11,11,11,11,11,11,11,11,11,11,11,11,10,10,10,10,10,10,10,10,10,10,10,10,10,10,10,10,10,10,10,10,10,10,10,9,9,9,9,9,9,9,9,9,9,9,9,8,8,8,8,8,8,8,7,6,5,4,3,2,1,0,17,18,19,20,21,22,23,24,24,24,24,24,24,24,25,25,25,25,25,25,25,25,25,25,25,25,26,26,26,26,26,26,26,26,26,26,26,26,26,26,26,26,26,26,26,26,26,26,26,27,27,27,27,27,27,27,27,27,27,27,27,27,27,27},
 {13,13,13,13,13,13,13,13,13,13,13,13,13,13,13,13,13,13,13,13,13,13,13,12,12,12,12,12,12,12,12,12,12,12,12,12,12,12,12,12,12,12,11,11,11,11,11,11,11,11,11,11,10,10,10,10,10,10,9,9,9,8,8,4,0,20,24,24,25,25,25,26,26,26,26,26,26,27,27,27,27,27,27,27,27,27,27,28,28,28,28,28,28,28,28,28,28,28,28,28,28,28,28,28,28,28,29,29,29,29,29,29,29,29,29,29,29,29,29,29,29,29,29,29,29,29,29,29,29},
 {15,15,15,15,15,15,15,15,15,15,15,15,15,15,15,15,15,15,15,15,15,15,15,15,15,15,15,15,15,15,14,14,14,14,14,14,14,14,14,14,14,14,14,14,14,13,13,13,13,13,13,13,13,13,12,12,12,12,12,11,11,10,10,9,0,25,26,26,27,27,28,28,28,28,28,29,29,29,29,29,29,29,29,29,30,30,30,30,30,30,30,30,30,30,30,30,30,30,30,31,31,31,31,31,31,31,31,31,31,31,31,31,31,31,31,31,31,31,31,31,31,31,31,31,31,31,31,31,31}};
__device__ __forceinline__ float wave_max(float v) {
#pragma unroll
    for (int o = 1; o < 64; o <<= 1) v = fmaxf(v, __shfl_xor(v, o));
    return v;
}
__device__ __forceinline__ float silu(float x) { return x / (1.f + __expf(-x)); }
__global__ void __launch_bounds__(256) gdn_pre_k(const bf16* __restrict__ qkva, const float* __restrict__ ab, const float* __restrict__ conv_w, const float* __restrict__ a_log, const float* __restrict__ dt_bias,
                                                 bf16* __restrict__ qkvc, float* __restrict__ gbuf, float* __restrict__ bbuf) {
    __shared__ float sums[12];
    const int t = blockIdx.x, tid = threadIdx.x;
    if (tid < 12) sums[tid] = 0.f;
    __syncthreads();
    float val[6];
#pragma unroll
    for (int i = 0; i < 6; ++i) {
        const int c = tid + 256 * i;
        float s = 0.f;
#pragma unroll
        for (int j = 0; j < CONVW; ++j) { const int tt = t + j - 2; if (tt >= 0 && tt < SEQ) s += bf2f(qkva[(size_t)tt * 1536 + c]) * conv_w[c * CONVW + j]; }
        val[i] = silu(s);
        if (c < 1024) atomicAdd(&sums[c >> 7], val[i] * val[i]);
    }
    __syncthreads();
#pragma unroll
    for (int i = 0; i < 6; ++i) {
        const int c = tid + 256 * i;
        float v = val[i];
        if (c < 1024) v *= rsqrtf(sums[c >> 7] + EPS);
        qkvc[(size_t)t * 1536 + c] = (bf16)f2bf(v);
    }
    if (tid < 8) {
        const float a = ab[(size_t)t * 16 + tid] + dt_bias[tid];
        const float sp = (a > 20.f) ? a : log1pf(expf(a));
        gbuf[(size_t)tid * SEQ + t] = -expf(a_log[tid]) * sp;
        const float b = ab[(size_t)t * 16 + 8 + tid];
        bbuf[(size_t)tid * SEQ + t] = 1.f / (1.f + expf(-b));
    }
}
__global__ void __launch_bounds__(1024) gdn_rec_k(const bf16* __restrict__ qkvc, const float* __restrict__ gbuf, const float* __restrict__ bbuf, float* __restrict__ o2) {
    const int dir = blockIdx.x >> 2, h = blockIdx.x & 3, tid = threadIdx.x, dv = tid >> 3, seg = tid & 7;
    float R[16];
#pragma unroll
    for (int i = 0; i < 16; ++i) R[i] = 0.f;
    const float* gp = gbuf + (size_t)(dir * 4 + h) * SEQ; const float* bp = bbuf + (size_t)(dir * 4 + h) * SEQ;
    float* op = o2 + (size_t)dir * SEQ * GW;
    const float qs = 0.08838834764831845f;
    for (int s = 0; s < SEQ; ++s) {
        const int t = dir ? (SEQ - 1 - s) : s;
        const bf16* row = qkvc + (size_t)t * 1536;
        float k[16], q[16];
#pragma unroll
        for (int i = 0; i < 16; ++i) { k[i] = bf2f(row[512 + h * 128 + seg * 16 + i]); q[i] = bf2f(row[h * 128 + seg * 16 + i]); }
        const float v = bf2f(row[1024 + h * 128 + dv]);
        const float eg = expf(gp[t]), beta = bp[t];
        float p = 0.f;
#pragma unroll
        for (int i = 0; i < 16; ++i) p += R[i] * k[i];
        p += __shfl_xor(p, 1); p += __shfl_xor(p, 2); p += __shfl_xor(p, 4);
        const float delta = beta * (v - eg * p);
        float o = 0.f;
#pragma unroll
        for (int i = 0; i < 16; ++i) { R[i] = eg * R[i] + delta * k[i]; o += R[i] * q[i]; }
        o += __shfl_xor(o, 1); o += __shfl_xor(o, 2); o += __shfl_xor(o, 4);
        if (seg == 0) op[(size_t)t * GW + h * 128 + dv] = o * qs;
    }
}
__global__ void __launch_bounds__(512) gdn_post_k(const float* __restrict__ o2, const bf16* __restrict__ z, const float* __restrict__ nw, bf16* __restrict__ mix, int ldm) {
    __shared__ float sums[4];
    const int t = blockIdx.x, c = threadIdx.x;
    if (c < 4) sums[c] = 0.f;
    __syncthreads();
    const float o = o2[(size_t)t * GW + c] + o2[(size_t)SEQ * GW + (size_t)t * GW + c];
    atomicAdd(&sums[c >> 7], o * o);
    __syncthreads();
    mix[(size_t)t * ldm + c] = (bf16)f2bf(o * rsqrtf(sums[c >> 7] * (1.f / 128.f) + EPS) * nw[c & 127] * silu(bf2f(z[(size_t)t * 512 + c])));
}
__global__ void __launch_bounds__(256) attn_k(const bf16* __restrict__ qb, const bf16* __restrict__ kb, const bf16* __restrict__ vb, const float* __restrict__ rel_bias, bf16* __restrict__ mix) {
    const int gw = blockIdx.x * 4 + (threadIdx.x >> 6), lane = threadIdx.x & 63;
    const int t = gw >> 3, h = gw & 7;
    const float qv = bf2f(qb[(size_t)t * 512 + h * 64 + lane]);
    float qa[64];
#pragma unroll
    for (int dd = 0; dd < 64; ++dd) qa[dd] = __shfl(qv, dd);
    float sc[7]; int pos[7];
    float mx = -1e30f;
#pragma unroll
    for (int r = 0; r < 7; ++r) {
        const int e = lane + 64 * r;
        float s = -1e30f; int kp = -1;
        if (e < 387) {
            const int p = e / 129, j = e % 129 - 64, d = (p == 0) ? 1 : (p == 1 ? 4 : 16);
            kp = t + d * j;
            if (kp >= 0 && kp < SEQ) {
                const bf16* kr = kb + (size_t)kp * 512 + h * 64;
                float a = 0.f;
#pragma unroll
                for (int dd = 0; dd < 64; ++dd) a += qa[dd] * bf2f(kr[dd]);
                s = a + rel_bias[(int)BUCKET[p][j + 64] * AH + h];
            } else kp = -1;
        }
        sc[r] = s; pos[r] = kp; mx = fmaxf(mx, s);
    }
    mx = wave_max(mx);
    float l = 0.f;
#pragma unroll
    for (int r = 0; r < 7; ++r) { sc[r] = (pos[r] >= 0) ? __expf(sc[r] - mx) : 0.f; l += sc[r]; }
    l = wave_sum(l);
    float o = 0.f;
#pragma unroll
    for (int r = 0; r < 7; ++r) {
        for (int src = 0; src < 64; ++src) {
            const float pe = __shfl(sc[r], src); const int kp = __shfl(pos[r], src);
            if (kp >= 0) o += pe * bf2f(vb[(size_t)kp * 512 + h * 64 + lane]);
        }
    }
    mix[(size_t)t * D + 512 + h * 64 + lane] = (bf16)f2bf(o / l);
}
__global__ void __launch_bounds__(512) diff_k(bf16* mine, const bf16* refv, unsigned* maxbits) {
    const int t = blockIdx.x, c = threadIdx.x;
    const float a = bf2f(mine[(size_t)t * D + c]), r = bf2f(refv[(size_t)t * 512 + c]);
    float d = fabsf(a - r); if (!(d == d)) d = 7777.f;
    d = wave_max(d);
    if ((c & 63) == 0) atomicMax(maxbits, __float_as_uint(d));
    mine[(size_t)t * D + c] = refv[(size_t)t * 512 + c];
}
__global__ void poke_k(float* out, const unsigned* maxbits) { out[0] = 1000.f * __uint_as_float(*maxbits); }
__global__ void poke_code_k(float* out, const unsigned* code) { out[0] = 1000.f * (float)(*code); }
__global__ void __launch_bounds__(256) nanpos_bf16_k(const bf16* p, size_t n, unsigned* w) {
    unsigned cnt = 0, best = 0;
    for (size_t i = (size_t)blockIdx.x * 256 + threadIdx.x; i < n; i += (size_t)gridDim.x * 256) { if ((p[i] & 0x7f80u) == 0x7f80u) { ++cnt; const unsigned inv = 0xffffffffu - (unsigned)i; best = inv > best ? inv : best; } }
    if (cnt) { atomicAdd(w, cnt); atomicMax(w + 1, best); }
}
__global__ void poke_nanpos_k(float* out, const unsigned* w) {
    const unsigned cnt = w[0]; const unsigned idx = w[1] ? 0xffffffffu - w[1] : 0u;
    int lc = 0; for (unsigned c = cnt; c >= 10; c /= 10) ++lc;
#if NANPOS_MODE == 0
    const unsigned code = (lc > 9 ? 9 : lc) * 10 + ((idx >> 13) & 127) / 16;
#elif NANPOS_MODE == 1
    const unsigned code = ((idx >> 10) & 7) * 10 + ((idx & 15) >> 1);
#else
    const unsigned code = ((idx >> 4) & 63);
#endif
    out[0] = 1000.f * (float)code;
}
__global__ void poke_cat3_k(float* out, const unsigned* mx) {
    unsigned code = 0;
    for (int k = 2; k >= 0; --k) { const float v = __uint_as_float(mx[k]); int cat = (v != v) ? 3 : (v < 2.f ? 0 : (v < 1e4f ? 1 : 2)); code = code * 4 + cat; }
    out[0] = 1000.f * (float)code;
}
__global__ void poke_cat_k(float* out, const unsigned* mx) {
    unsigned code = 0;
    for (int k = 1; k >= 0; --k) { const float v = __uint_as_float(mx[k]); int cat = (v != v) ? 5 : (v < 10.f ? 0 : (v < 100.f ? 1 : (v < 1e4f ? 2 : (v < 1e10f ? 3 : 4)))); code = code * 6 + cat; }
    out[0] = 1000.f * (float)code;
}
__global__ void __launch_bounds__(256) maxabs_bf16_k(const bf16* p, size_t n, unsigned* mx) {
    unsigned best = 0;
    for (size_t i = (size_t)blockIdx.x * 256 + threadIdx.x; i < n; i += (size_t)gridDim.x * 256) { const unsigned b = ((unsigned)p[i] << 16) & 0x7fffffffu; best = b > best ? b : best; }
    atomicMax(mx, best);
}
__global__ void __launch_bounds__(256) chk_bf16_k(const bf16* p, size_t n, unsigned* code, unsigned bit) {
    bool bad = false;
    for (size_t i = (size_t)blockIdx.x * 256 + threadIdx.x; i < n; i += (size_t)gridDim.x * 256) { const float v = bf2f(p[i]); if (!(fabsf(v) < 1e4f)) bad = true; }
    if (__any(bad) && (threadIdx.x & 63) == 0) atomicOr(code, bit);
}
__global__ void __launch_bounds__(256) chk_f32_k(const float* p, size_t n, unsigned* code, unsigned bit) {
    bool bad = false;
    for (size_t i = (size_t)blockIdx.x * 256 + threadIdx.x; i < n; i += (size_t)gridDim.x * 256) { const float v = p[i]; if (!(fabsf(v) < 1e4f)) bad = true; }
    if (__any(bad) && (threadIdx.x & 63) == 0) atomicOr(code, bit);
}
}

extern "C" void kernel_launch(void* const* d_in, const int* in_sizes, int n_in, void* d_out, int out_size, void* d_ws, size_t ws_size, hipStream_t stream) {
    static int grid = 0;
    if (grid == 0) {
        if (n_in != 20 || in_sizes[0] != M * D || out_size != M * D || ws_size < WS_END) { fprintf(stderr, "kernel_launch: unexpected shapes (n_in %d, in0 %d, out %d, ws %zu)\n", n_in, n_in > 0 ? in_sizes[0] : -1, out_size, ws_size); grid = -1; return; }
        int dev = 0, cus = 0, per_cu = 0;
        if (hipGetDevice(&dev) != hipSuccess || hipDeviceGetAttribute(&cus, hipDeviceAttributeMultiprocessorCount, dev) != hipSuccess) { grid = -1; return; }
        if (hipFuncSetAttribute((const void*)mk_fwd, hipFuncAttributeMaxDynamicSharedMemorySize, LDS_BYTES) != hipSuccess) { fprintf(stderr, "kernel_launch: hipFuncSetAttribute failed\n"); grid = -1; return; }
        if (hipOccupancyMaxActiveBlocksPerMultiprocessor(&per_cu, (const void*)mk_fwd, NWAVES * 64, LDS_BYTES) != hipSuccess || per_cu < 1) { fprintf(stderr, "kernel_launch: occupancy query reports %d\n", per_cu); per_cu = 1; }
        (void)hipGetLastError();
        grid = cus;
    }
    if (grid < 0) return;
    unsigned char* ws = (unsigned char*)d_ws;
    (void)hipMemsetAsync(ws + WS_CTL, 0, CTL_ZERO_BYTES, stream);
    Args a{};
    for (int i = 0; i < 20; ++i) a.in[i] = (const float*)d_in[i];
    a.out = (float*)d_out; a.ws = ws;
    a.ph_lo = 0; a.ph_hi = N_PHASES; a.li = 0;
    hipLaunchKernelGGL(mk_fwd, dim3(grid), dim3(NWAVES * 64), LDS_BYTES, stream, a);
}
```
